# Optimizing an MI355X kernel written in HIP

```python
import jax, jax.numpy as jnp
from jax import lax
import numpy as np

D_MODEL = 1024
BATCH = 4
SEQ = 4096
DEPTH = 4
DEC_BATCH = 2
DEC_SEQ = 8192
PAST_LEN = 128

D_FF = 2816
NORM_EPS = 1e-6
ROPE_THETA = 10000.0
BLOCK = 128

MLA_HEADS = 8
MLA_Q_RANK = 256
MLA_KV_RANK = 128
MLA_NOPE = 64
MLA_ROPE = 32
MLA_V = 64

CONV_WIDTH = 512
CONV_K = 3

SWA_HEADS = 8
SWA_KV_HEADS = 2
SWA_HEAD_DIM = 64
SWA_WINDOW = 128

N_BRANCHES = 3

MLA_COLS = MLA_Q_RANK + MLA_KV_RANK + MLA_ROPE
CONV_COLS = 3 * CONV_WIDTH
SWA_Q_COLS = SWA_HEADS * SWA_HEAD_DIM
SWA_KV_COLS = SWA_KV_HEADS * SWA_HEAD_DIM
SWA_COLS = SWA_Q_COLS + 2 * SWA_KV_COLS
GATE_COLS = N_BRANCHES * D_MODEL
IN_COLS = MLA_COLS + CONV_COLS + SWA_COLS + GATE_COLS

kernel_name = "hybrid_mla_conv_swa_encoder"


def rmsnorm(x, g):
    xf = x.astype(jnp.float32)
    y = xf * lax.rsqrt(jnp.mean(xf * xf, axis=-1, keepdims=True) + NORM_EPS)
    return (y * g.astype(jnp.float32)).astype(x.dtype)


def rope_tables(seq, dim):
    inv = 1.0 / (ROPE_THETA ** (jnp.arange(0, dim, 2, dtype=jnp.float32) / dim))
    ang = jnp.arange(seq, dtype=jnp.float32)[:, None] * inv[None, :]
    return jnp.cos(ang), jnp.sin(ang)


def apply_rope(x, cos, sin):
    xf = x.astype(jnp.float32)
    x1, x2 = jnp.split(xf, 2, axis=-1)
    out = jnp.concatenate([x1 * cos - x2 * sin, x2 * cos + x1 * sin], axis=-1)
    return out.astype(x.dtype)


def swiglu_ffn(x, g, w_gu, w_down):
    h = rmsnorm(x, g) @ w_gu
    a, b = jnp.split(h, 2, axis=-1)
    return (jax.nn.silu(a) * b) @ w_down


def mla_mixer(q_lat, kv_lat, k_rope_raw, q_norm, w_uq, kv_norm, w_ukv, w_out, cos, sin):
    B, S, _ = q_lat.shape
    nb = S // BLOCK
    q = (rmsnorm(q_lat, q_norm) @ w_uq).reshape(B, S, MLA_HEADS, MLA_NOPE + MLA_ROPE)
    q_nope = q[..., :MLA_NOPE]
    q_rope = apply_rope(q[..., MLA_NOPE:], cos[:, None, :], sin[:, None, :])
    kv = (rmsnorm(kv_lat, kv_norm) @ w_ukv).reshape(B, S, MLA_HEADS, MLA_NOPE + MLA_V)
    k_nope = kv[..., :MLA_NOPE]
    v = kv[..., MLA_NOPE:]
    k_rope = apply_rope(k_rope_raw, cos, sin)
    scale = (MLA_NOPE + MLA_ROPE) ** -0.5
    qn = q_nope.reshape(B, nb, BLOCK, MLA_HEADS, MLA_NOPE).transpose(1, 0, 2, 3, 4)
    qr = q_rope.reshape(B, nb, BLOCK, MLA_HEADS, MLA_ROPE).transpose(1, 0, 2, 3, 4)

    def attend(qb):
        qn_b, qr_b = qb
        s = (jnp.einsum('bqhd,bkhd->bhqk', qn_b, k_nope)
             + jnp.einsum('bqhr,bkr->bhqk', qr_b, k_rope)).astype(jnp.float32) * scale
        p = jax.nn.softmax(s, axis=-1).astype(v.dtype)
        return jnp.einsum('bhqk,bkhd->bqhd', p, v)

    o = lax.map(attend, (qn, qr))
    o = o.transpose(1, 0, 2, 3, 4).reshape(B, S, MLA_HEADS * MLA_V)
    return o @ w_out


def short_conv_mixer(cols, conv_w, w_out):
    S = cols.shape[1]
    b_gate, c_gate, x_in = jnp.split(cols, 3, axis=-1)
    z = c_gate * x_in
    half = CONV_K // 2
    zp = jnp.pad(z, ((0, 0), (half, half), (0, 0)))
    y = sum(zp[:, k:k + S, :] * conv_w[k] for k in range(CONV_K))
    return (b_gate * y) @ w_out


def swa_mixer(q, k, v, sink, w_out, cos, sin):
    B, S = q.shape[0], q.shape[1]
    nb = S // BLOCK
    G = SWA_HEADS // SWA_KV_HEADS
    q = apply_rope(q.reshape(B, S, SWA_HEADS, SWA_HEAD_DIM), cos[:, None, :], sin[:, None, :])
    k = apply_rope(k.reshape(B, S, SWA_KV_HEADS, SWA_HEAD_DIM), cos[:, None, :], sin[:, None, :])
    v = v.reshape(B, S, SWA_KV_HEADS, SWA_HEAD_DIM)
    qb = q.reshape(B, nb, BLOCK, SWA_KV_HEADS, G, SWA_HEAD_DIM)

    def band(t):
        tp = jnp.pad(t, ((0, 0), (BLOCK, BLOCK), (0, 0), (0, 0)))
        tp = tp.reshape(B, nb + 2, BLOCK, SWA_KV_HEADS, SWA_HEAD_DIM)
        return jnp.concatenate([tp[:, :-2], tp[:, 1:-1], tp[:, 2:]], axis=2)

    kw, vw = band(k), band(v)
    a = jnp.arange(BLOCK)[:, None]
    c = jnp.arange(3 * BLOCK)[None, :]
    rel = c - BLOCK - a
    j = jnp.arange(nb)[:, None, None] * BLOCK - BLOCK + c[None]
    mask = (jnp.abs(rel) <= SWA_WINDOW)[None] & (j >= 0) & (j < S)
    scale = SWA_HEAD_DIM ** -0.5
    s = jnp.einsum('bnqhgd,bnkhd->bnhgqk', qb, kw).astype(jnp.float32) * scale
    s = jnp.where(mask[None, :, None, None], s, -1e30)
    sk = sink.astype(jnp.float32).reshape(SWA_KV_HEADS, G)[None, None, :, :, None, None]
    m = jnp.maximum(jnp.max(s, axis=-1, keepdims=True), sk)
    p = jnp.exp(s - m)
    denom = jnp.sum(p, axis=-1, keepdims=True) + jnp.exp(sk - m)
    p = (p / denom).astype(v.dtype)
    o = jnp.einsum('bnhgqk,bnkhd->bnqhgd', p, vw).reshape(B, S, SWA_HEADS * SWA_HEAD_DIM)
    return o @ w_out


def encoder_layer(x, p, l, mla_cs, swa_cs):
    B, S, D = x.shape
    x = x + 0.5 * swiglu_ffn(x, p['ffn1_norm'][l], p['ffn1_w_gu'][l], p['ffn1_w_down'][l])
    u = rmsnorm(x, p['mix_norm'][l])
    cols = u @ p['w_in'][l]
    o0 = 0
    q_lat = cols[..., o0:o0 + MLA_Q_RANK]; o0 += MLA_Q_RANK
    kv_lat = cols[..., o0:o0 + MLA_KV_RANK]; o0 += MLA_KV_RANK
    k_rope_raw = cols[..., o0:o0 + MLA_ROPE]; o0 += MLA_ROPE
    conv_cols = cols[..., o0:o0 + CONV_COLS]; o0 += CONV_COLS
    sq = cols[..., o0:o0 + SWA_Q_COLS]; o0 += SWA_Q_COLS
    sk = cols[..., o0:o0 + SWA_KV_COLS]; o0 += SWA_KV_COLS
    sv = cols[..., o0:o0 + SWA_KV_COLS]; o0 += SWA_KV_COLS
    gate_cols = cols[..., o0:o0 + GATE_COLS]

    y_a = mla_mixer(q_lat, kv_lat, k_rope_raw, p['mla_q_norm'][l], p['mla_w_uq'][l],
                    p['mla_kv_norm'][l], p['mla_w_ukv'][l], p['mla_w_o'][l], *mla_cs)
    y_b = short_conv_mixer(conv_cols, p['conv_w'][l], p['conv_w_o'][l])
    y_c = swa_mixer(sq, sk, sv, p['swa_sink'][l], p['swa_w_o'][l], *swa_cs)

    gates = jax.nn.sigmoid(gate_cols.astype(jnp.float32)).astype(x.dtype).reshape(B, S, N_BRANCHES, D)
    merged = gates[:, :, 0] * y_a + gates[:, :, 1] * y_b + gates[:, :, 2] * y_c
    x = x + merged @ p['w_o'][l]
    x = x + 0.5 * swiglu_ffn(x, p['ffn2_norm'][l], p['ffn2_w_gu'][l], p['ffn2_w_down'][l])
    return x


def encode(x, p, final_norm):
    S = x.shape[1]
    mla_cs = rope_tables(S, MLA_ROPE)
    swa_cs = rope_tables(S, SWA_HEAD_DIM)
    for l in range(DEPTH):
        x = encoder_layer(x, p, l, mla_cs, swa_cs)
    return rmsnorm(x, final_norm)


def setup_inputs(seed: int = 0) -> dict:
    key = jax.random.key(seed)
    ks = jax.random.split(key, 24)

    def w(k, shape, fan_in):
        return jax.random.normal(k, shape, jnp.float32) * (fan_in ** -0.5)

    def gain(k, shape):
        return 1.0 + 0.02 * jax.random.normal(k, shape, jnp.float32)

    L = DEPTH
    return {
        "x_prompt": jax.random.normal(ks[0], (BATCH, SEQ, D_MODEL), jnp.float32),
        "x_sample": jax.random.normal(ks[1], (DEC_BATCH, DEC_SEQ, D_MODEL), jnp.float32),
        "ffn1_norm": gain(ks[2], (L, D_MODEL)),
        "ffn1_w_gu": w(ks[3], (L, D_MODEL, 2 * D_FF), D_MODEL),
        "ffn1_w_down": w(ks[4], (L, D_FF, D_MODEL), D_FF),
        "mix_norm": gain(ks[5], (L, D_MODEL)),
        "w_in": w(ks[6], (L, D_MODEL, IN_COLS), D_MODEL),
        "mla_q_norm": gain(ks[7], (L, MLA_Q_RANK)),
        "mla_w_uq": w(ks[8], (L, MLA_Q_RANK, MLA_HEADS * (MLA_NOPE + MLA_ROPE)), MLA_Q_RANK),
        "mla_kv_norm": gain(ks[9], (L, MLA_KV_RANK)),
        "mla_w_ukv": w(ks[10], (L, MLA_KV_RANK, MLA_HEADS * (MLA_NOPE + MLA_V)), MLA_KV_RANK),
        "mla_w_o": w(ks[11], (L, MLA_HEADS * MLA_V, D_MODEL), MLA_HEADS * MLA_V),
        "conv_w": w(ks[12], (L, CONV_K, CONV_WIDTH), CONV_K),
        "conv_w_o": w(ks[13], (L, CONV_WIDTH, D_MODEL), CONV_WIDTH),
        "swa_sink": 0.5 * jax.random.normal(ks[14], (L, SWA_HEADS), jnp.float32),
        "swa_w_o": w(ks[15], (L, SWA_HEADS * SWA_HEAD_DIM, D_MODEL), SWA_HEADS * SWA_HEAD_DIM),
        "w_o": w(ks[16], (L, D_MODEL, D_MODEL), D_MODEL),
        "ffn2_norm": gain(ks[17], (L, D_MODEL)),
        "ffn2_w_gu": w(ks[18], (L, D_MODEL, 2 * D_FF), D_MODEL),
        "ffn2_w_down": w(ks[19], (L, D_FF, D_MODEL), D_FF),
        "final_norm": gain(ks[20], (D_MODEL,)),
    }


def reference(x_prompt, x_sample, ffn1_norm, ffn1_w_gu, ffn1_w_down, mix_norm, w_in,
              mla_q_norm, mla_w_uq, mla_kv_norm, mla_w_ukv, mla_w_o, conv_w, conv_w_o,
              swa_sink, swa_w_o, w_o, ffn2_norm, ffn2_w_gu, ffn2_w_down, final_norm):
    p = {
        'ffn1_norm': ffn1_norm, 'ffn1_w_gu': ffn1_w_gu, 'ffn1_w_down': ffn1_w_down,
        'mix_norm': mix_norm, 'w_in': w_in,
        'mla_q_norm': mla_q_norm, 'mla_w_uq': mla_w_uq, 'mla_kv_norm': mla_kv_norm,
        'mla_w_ukv': mla_w_ukv, 'mla_w_o': mla_w_o,
        'conv_w': conv_w, 'conv_w_o': conv_w_o,
        'swa_sink': swa_sink, 'swa_w_o': swa_w_o, 'w_o': w_o,
        'ffn2_norm': ffn2_norm, 'ffn2_w_gu': ffn2_w_gu, 'ffn2_w_down': ffn2_w_down,
    }
    y_prompt = encode(x_prompt, p, final_norm)
    y_sample = encode(x_sample, p, final_norm)
    return (y_prompt, y_sample)
```

```cpp
#include <hip/hip_runtime.h>
#include <hip/hip_cooperative_groups.h>
#include <cstdio>
#include <cstdint>
namespace cg = cooperative_groups;

#ifndef ONE_LAUNCH
#define ONE_LAUNCH 1
#endif

#ifndef DUP_SUB
#define DUP_SUB -1
#endif
#ifndef ONLY
#define ONLY -1
#endif
#define PON(k) (ONLY < 0 || ONLY == (k))
#define LAS __attribute__((address_space(3)))
typedef unsigned short bf16_t;
typedef short bf16x8 __attribute__((ext_vector_type(8)));
typedef float f32x4 __attribute__((ext_vector_type(4)));
typedef float f32x16 __attribute__((ext_vector_type(16)));
typedef unsigned u32x4 __attribute__((ext_vector_type(4)));
typedef unsigned u32x2 __attribute__((ext_vector_type(2)));
typedef float f32x2_t __attribute__((ext_vector_type(2)));
typedef __bf16 bf16x2_t __attribute__((ext_vector_type(2)));

constexpr int T = 32768, TP = 16384, DM = 1024, FF = 2816;
constexpr float EPS = 1e-6f, LOG2E = 1.4426950408889634f;
constexpr int NPH = 85;

constexpr size_t MiB = 1u << 20;
constexpr size_t WS_SSQQ = 0, WS_SSQKV = 524288;
constexpr size_t WS_TABM = 1 * MiB, WS_TABS = 2 * MiB;
constexpr size_t WS_W = 4 * MiB;
constexpr size_t WS_BAR = 55 * MiB, BAR_BYTES = 16384;
constexpr size_t WS_HB = 56 * MiB;
constexpr size_t WS_BIG = 120 * MiB;
constexpr size_t WS_ACT = WS_BIG;
constexpr size_t WS_LAT = WS_BIG;
constexpr size_t WS_CONVB = WS_BIG + 32 * MiB;
constexpr size_t WS_CONVZ = WS_BIG + 64 * MiB;
constexpr size_t WS_SWAQK = WS_BIG + 96 * MiB;
constexpr size_t WS_SWAVT = WS_BIG + 144 * MiB;
constexpr size_t WS_CB = WS_BIG + 152 * MiB;
constexpr size_t WS_Q = WS_BIG + 184 * MiB;
constexpr size_t WS_KNOPE = WS_BIG + 232 * MiB;
constexpr size_t WS_VT = WS_BIG + 264 * MiB;
constexpr size_t WS_G = WS_BIG + 296 * MiB;
constexpr size_t WS_MERGED = WS_Q;
constexpr size_t WS_SSQX = WS_BIG + 360 * MiB;
constexpr size_t WS_END = WS_BIG + 362 * MiB;
constexpr size_t O_GU1 = 0, O_DN1 = 11534336, O_GU2 = 17301504, O_DN2 = 28835840, O_WIN = 34603008, O_WG = 40370176, O_WSV = 46661632,
                 O_WUQ = 47185920, O_WUK = 47579136, O_WUV = 47710208, O_WAO = 47841280, O_WBO = 48889856, O_WCO = 49938432, O_WO = 50987008;

constexpr int LDS_BYTES = 147456;

__device__ __forceinline__ unsigned pk2(float lo, float hi) { f32x2_t v = {lo, hi}; bf16x2_t b = __builtin_convertvector(v, bf16x2_t); return __builtin_bit_cast(unsigned, b); }
__device__ __forceinline__ float bflo(unsigned u) { return __uint_as_float(u << 16); }
__device__ __forceinline__ float bfhi(unsigned u) { return __uint_as_float(u & 0xffff0000u); }
__device__ __forceinline__ u32x4 pack8(f32x4 a, f32x4 b) { u32x4 w; w.x = pk2(a[0], a[1]); w.y = pk2(a[2], a[3]); w.z = pk2(b[0], b[1]); w.w = pk2(b[2], b[3]); return w; }
__device__ __forceinline__ void unpack8(u32x4 w, f32x4& a, f32x4& b) { a = (f32x4){bflo(w.x), bfhi(w.x), bflo(w.y), bfhi(w.y)}; b = (f32x4){bflo(w.z), bfhi(w.z), bflo(w.w), bfhi(w.w)}; }
__device__ __forceinline__ float wave_sum(float v) {
#pragma unroll
    for (int o = 1; o < 64; o <<= 1) v += __shfl_xor(v, o);
    return v;
}
__device__ __forceinline__ float fast_sigmoid(float x) { return __builtin_amdgcn_rcpf(1.0f + __builtin_amdgcn_exp2f(-x * LOG2E)); }
__device__ __forceinline__ int tok_pos(int row) { return row < TP ? (row & 4095) : (row & 8191); }
__device__ __forceinline__ void rope8(f32x4& v0, f32x4& v1, const float* tab) {
    const f32x4 t0 = *(const f32x4*)tab, t1 = *(const f32x4*)(tab + 4);
    float a, b;
    a = v0[0] * t0[0] - v0[1] * t0[1]; b = v0[1] * t0[0] + v0[0] * t0[1]; v0[0] = a; v0[1] = b;
    a = v0[2] * t0[2] - v0[3] * t0[3]; b = v0[3] * t0[2] + v0[2] * t0[3]; v0[2] = a; v0[3] = b;
    a = v1[0] * t1[0] - v1[1] * t1[1]; b = v1[1] * t1[0] + v1[0] * t1[1]; v1[0] = a; v1[1] = b;
    a = v1[2] * t1[2] - v1[3] * t1[3]; b = v1[3] * t1[2] + v1[2] * t1[3]; v1[2] = a; v1[3] = b;
}

__device__ __forceinline__ float row_rs16(const float* ssq_x, int row) {
    const f32x4* p = (const f32x4*)(ssq_x + (size_t)row * 16); const f32x4 a = p[0], b = p[1], c = p[2], d = p[3];
    return rsqrtf((((a[0] + a[1]) + (a[2] + a[3])) + ((b[0] + b[1]) + (b[2] + b[3])) + ((c[0] + c[1]) + (c[2] + c[3])) + ((d[0] + d[1]) + (d[2] + d[3]))) * (1.0f / DM) + EPS);
}

struct RsCtx { const LAS float* t; int p0, p1; const float* ssq_x;
    __device__ __forceinline__ float get(int key, int idx, int row) const { return key == p0 ? t[idx] : key == p1 ? t[256 + idx] : row_rs16(ssq_x, row); } };

namespace pg8 {
constexpr int BM = 256, BK = 64, HALF = 128, HTB = HALF * BK * 2, STAGE_BYTES = 8 * HTB, NXCD = 8, WGM = 8;
__host__ __device__ __forceinline__ int lds_byte(int r, int c) { const int st = (r >> 4) * 2 + (c >> 5), rr = r & 15, cc = c & 31, ob = rr * 64 + cc * 2; return st * 1024 + (ob ^ (((ob >> 9) & 1) << 5)); }
__host__ __device__ __forceinline__ void stage_rc(int b, int& R, int& C) { const int st = b / 1024, sb = b % 1024, swz = sb ^ (((sb >> 9) & 1) << 5); R = (st >> 1) * 16 + swz / 64; C = (st & 1) * 32 + (swz % 64) / 2; }
__host__ __device__ __forceinline__ int perm32(int rho) { const int n = rho >> 4, i = rho & 15; return 8 * (i >> 2) + 4 * n + (i & 3); }

struct Unit { int pm, pn, kind; };
struct Gemm { const bf16_t* A; const bf16_t* Bt; int M, N, K, lda, ldb; };

struct StaticOrder {
    int nM, nN, nwg, G, c;
    __host__ __device__ void init(int M, int N, int G_, int c_) { nM = M / BM; nN = N / BM; nwg = nM * nN; G = G_; c = c_; }
    __host__ __device__ bool next(int i, Unit& u) const {
        const long L = (long)i * G + c; if (L >= nwg) return false;
        int wgid = (int)L; { const int q = nwg / NXCD, r = nwg % NXCD, xcd = wgid % NXCD, off = wgid / NXCD; wgid = (xcd < r ? xcd * (q + 1) : r * (q + 1) + (xcd - r) * q) + off; }
        const int nig = WGM * nN, gid = wgid / nig, fm = gid * WGM, gsz = (nM - fm) < WGM ? (nM - fm) : WGM;
        u.pm = fm + ((wgid % nig) % gsz); u.pn = (wgid % nig) / gsz; u.kind = 0; return true;
    }
};

template <class Epi, class Sched, bool ALIGN_EPI = true>
__device__ __forceinline__ void gemm_phase(LAS unsigned char* lds, const Gemm g, const Sched S, const Epi E, const int tid) {
    const int wid = __builtin_amdgcn_readfirstlane(tid >> 6), lane = tid & 63, wr = wid >> 2, wc = wid & 3, fr = lane & 15, fq = lane >> 4;
    int K = g.K; asm volatile("" : "+s"(K)); const int nt = K / BK;
    unsigned voffA[2], voffB[2];
#pragma unroll
    for (int i = 0; i < 2; ++i) { int R, C; stage_rc(tid * 16 + i * 8192, R, C); const int Rb = (R & ~31) + perm32(R & 31);
        voffA[i] = (unsigned)(R * g.lda + C) * 2u; voffB[i] = (unsigned)(Rb * g.ldb + C) * 2u; }
    const size_t kstep = (size_t)(BK * 2);
    const size_t hstepA = (size_t)HALF * g.lda * 2, hstepB = (size_t)HALF * g.ldb * 2;
    const size_t tstepA = 2 * hstepA, tstepB = 2 * hstepB;
    const unsigned ldsw = (unsigned)wid * 1024u;
    const int aoff = lds_byte(wr * 64 + fr, fq * 8), boff = lds_byte(wc * 32 + fr, fq * 8);
#define PG8_SA(b, h) (((b) * 2 + (h)) * HTB)
#define PG8_SB(b, h) ((4 + (b) * 2 + (h)) * HTB)
#define PG8_STAGE(bufoff, gbase, voff) do { _Pragma("unroll") for (int _i = 0; _i < 2; ++_i) \
        __builtin_amdgcn_global_load_lds((const unsigned*)((const char*)(gbase) + (voff)[_i]), (LAS unsigned*)(lds + (bufoff) + ldsw + _i * 8192), 16, 0, 0); } while (0)
#define PG8_LDA(dst, b, h) do { _Pragma("unroll") for (int m = 0; m < 4; ++m) _Pragma("unroll") for (int k = 0; k < 2; ++k) dst[m][k] = *(const LAS bf16x8*)(lds + PG8_SA(b, h) + aoff + m * 2048 + k * 1024); } while (0)
#define PG8_LDB(dst, b, h) do { _Pragma("unroll") for (int n = 0; n < 2; ++n) _Pragma("unroll") for (int k = 0; k < 2; ++k) dst[n][k] = *(const LAS bf16x8*)(lds + PG8_SB(b, h) + boff + n * 2048 + k * 1024); } while (0)
#define PG8_MMA(ai, bj, At, Bt) do { __builtin_amdgcn_s_setprio(1); _Pragma("unroll") for (int m = 0; m < 4; ++m) _Pragma("unroll") for (int n = 0; n < 2; ++n) _Pragma("unroll") for (int k = 0; k < 2; ++k) \
        acc[ai][bj][m][n] = __builtin_amdgcn_mfma_f32_16x16x32_bf16(Bt[n][k], At[m][k], acc[ai][bj][m][n], 0, 0, 0); __builtin_amdgcn_s_setprio(0); } while (0)
#define PG8_WAIT_V(n) asm volatile("s_waitcnt vmcnt(" #n ")" ::: "memory")
#define PG8_WAIT_L(n) asm volatile("s_waitcnt lgkmcnt(" #n ")" ::: "memory")
#define PG8_BAR __builtin_amdgcn_s_barrier()
#define PG8_SCHED __builtin_amdgcn_sched_barrier(0)
    Unit cur, nxt; int ui = 0;
    if (!S.next(0, cur)) return;
    RsCtx rc; rc.t = (const LAS float*)(lds + 132096); rc.p0 = -1; rc.p1 = -1; rc.ssq_x = nullptr;
    if constexpr (Epi::RS16 != 0) {
        rc.ssq_x = E.ssq_x; Unit uu;
        for (int i = 0; S.next(i, uu); ++i) { const int key = Epi::RS16 == 2 ? uu.pn : uu.pm; if (key != rc.p0 && key != rc.p1) { if (rc.p0 < 0) rc.p0 = key; else if (rc.p1 < 0) rc.p1 = key; } }
        const int key = tid < 256 ? rc.p0 : rc.p1;
        if (key >= 0) ((LAS float*)(lds + 132096))[tid] = row_rs16(E.ssq_x, key * 256 + (tid & 255));
        asm volatile("s_waitcnt vmcnt(0) lgkmcnt(0)" ::: "memory"); __builtin_amdgcn_s_barrier(); asm volatile("" ::: "memory");
    }
    f32x4 acc[2][2][4][2];
#pragma unroll
    for (int a = 0; a < 2; ++a)
#pragma unroll
        for (int b = 0; b < 2; ++b)
#pragma unroll
            for (int m = 0; m < 4; ++m)
#pragma unroll
                for (int n = 0; n < 2; ++n) acc[a][b][m][n] = (f32x4){0.f, 0.f, 0.f, 0.f};
    bf16x8 At[4][2], B0[2][2], B1[2][2];
    const char* cA = (const char*)g.A + (size_t)cur.pm * tstepA; const char* cB = (const char*)g.Bt + (size_t)cur.pn * tstepB;
    PG8_STAGE(PG8_SB(0, 0), cB, voffB); PG8_STAGE(PG8_SB(0, 1), cB + hstepB, voffB); PG8_STAGE(PG8_SA(0, 0), cA, voffA); PG8_STAGE(PG8_SA(0, 1), cA + hstepA, voffA);
    if (wr == 1) PG8_BAR;
    PG8_WAIT_V(2); PG8_BAR;
    PG8_STAGE(PG8_SB(1, 0), cB + kstep, voffB); PG8_STAGE(PG8_SA(1, 0), cA + kstep, voffA); PG8_STAGE(PG8_SB(1, 1), cB + hstepB + kstep, voffB);
    PG8_WAIT_V(6); PG8_BAR;
    for (;;) {
        const bool has_next = S.next(ui + 1, nxt);
        const char* nA = has_next ? (const char*)g.A + (size_t)nxt.pm * tstepA : cA; const char* nB = has_next ? (const char*)g.Bt + (size_t)nxt.pn * tstepB : cB;
        for (int t = 0; t < nt; t += 2) {
            const bool last = (t == nt - 2);
            const char* a1 = cA + (size_t)(t + 1) * kstep;
            const char* a2 = last ? nA : cA + (size_t)(t + 2) * kstep; const char* b2 = last ? nB : cB + (size_t)(t + 2) * kstep;
            const char* a3 = a2 + kstep; const char* b3 = b2 + kstep;
            PG8_LDB(B0, 0, 0); PG8_LDB(B1, 0, 1); PG8_SCHED; PG8_LDA(At, 0, 0); PG8_STAGE(PG8_SA(1, 1), a1 + hstepA, voffA);
            PG8_WAIT_V(8); PG8_WAIT_L(0); PG8_BAR; PG8_MMA(0, 0, At, B0); PG8_MMA(0, 1, At, B1); PG8_BAR; PG8_SCHED;
            PG8_LDA(At, 0, 1); PG8_STAGE(PG8_SB(0, 0), b2, voffB); PG8_STAGE(PG8_SB(0, 1), b2 + hstepB, voffB); PG8_STAGE(PG8_SA(0, 0), a2, voffA);
            PG8_WAIT_V(8); PG8_WAIT_L(0); PG8_BAR; PG8_MMA(1, 0, At, B0); PG8_MMA(1, 1, At, B1); PG8_BAR; PG8_SCHED;
            PG8_LDB(B0, 1, 0); PG8_LDB(B1, 1, 1); PG8_SCHED; PG8_LDA(At, 1, 0); PG8_STAGE(PG8_SA(0, 1), a2 + hstepA, voffA);
            PG8_WAIT_V(8); PG8_WAIT_L(0); PG8_BAR; PG8_MMA(0, 0, At, B0); PG8_MMA(0, 1, At, B1); PG8_BAR; PG8_SCHED;
            PG8_LDA(At, 1, 1); PG8_STAGE(PG8_SB(1, 0), b3, voffB); PG8_STAGE(PG8_SB(1, 1), b3 + hstepB, voffB); PG8_STAGE(PG8_SA(1, 0), a3, voffA);
            PG8_WAIT_V(8); PG8_WAIT_L(0); PG8_BAR; PG8_MMA(1, 0, At, B0); PG8_MMA(1, 1, At, B1); PG8_BAR; PG8_SCHED;
        }
        if constexpr (ALIGN_EPI) { if (wr == 0) PG8_BAR; }
        E(acc, cur, wr, wc, fr, fq, rc);
        if (!has_next) break;
#pragma unroll
        for (int a = 0; a < 2; ++a)
#pragma unroll
            for (int b = 0; b < 2; ++b)
#pragma unroll
                for (int m = 0; m < 4; ++m)
#pragma unroll
                    for (int n = 0; n < 2; ++n) acc[a][b][m][n] = (f32x4){0.f, 0.f, 0.f, 0.f};
        cur = nxt; cA = nA; cB = nB; ++ui;
        if constexpr (ALIGN_EPI) { if (wr == 1) PG8_BAR; }
    }
    PG8_WAIT_V(0);
    if constexpr (!ALIGN_EPI) { if (wr == 0) PG8_BAR; }
    PG8_BAR;
#undef PG8_SA
#undef PG8_SB
#undef PG8_STAGE
#undef PG8_LDA
#undef PG8_LDB
#undef PG8_MMA
#undef PG8_WAIT_V
#undef PG8_WAIT_L
#undef PG8_BAR
#undef PG8_SCHED
}

template <class Epi, class Sched, class GSel>
__device__ __forceinline__ void gemm_multi(LAS unsigned char* lds, const GSel GS, const Sched S, const Epi E, const int tid) {
    const int wid = __builtin_amdgcn_readfirstlane(tid >> 6), lane = tid & 63, wr = wid >> 2, wc = wid & 3, fr = lane & 15, fq = lane >> 4;
    const size_t kstep = (size_t)(BK * 2);
    const unsigned ldsw = (unsigned)wid * 1024u;
    const int aoff = lds_byte(wr * 64 + fr, fq * 8), boff = lds_byte(wc * 32 + fr, fq * 8);
#define PGM_VOFF(vA, vB, g) do { int R_, C_; stage_rc(tid * 16, R_, C_); const int Rb_ = (R_ & ~31) + perm32(R_ & 31); \
        vA = (unsigned)(R_ * (g).lda + C_) * 2u; vB = (unsigned)(Rb_ * (g).ldb + C_) * 2u; } while (0)
#define PG8_SA(b, h) (((b) * 2 + (h)) * HTB)
#define PG8_SB(b, h) ((4 + (b) * 2 + (h)) * HTB)
#define PG8_STAGE(bufoff, gbase, voff, q64) do { \
        __builtin_amdgcn_global_load_lds((const unsigned*)((const char*)(gbase) + (voff)), (LAS unsigned*)(lds + (bufoff) + ldsw), 16, 0, 0); \
        __builtin_amdgcn_global_load_lds((const unsigned*)((const char*)(gbase) + (q64) + (voff)), (LAS unsigned*)(lds + (bufoff) + ldsw + 8192), 16, 0, 0); } while (0)
#define PG8_LDA(dst, b, h) do { _Pragma("unroll") for (int m = 0; m < 4; ++m) _Pragma("unroll") for (int k = 0; k < 2; ++k) dst[m][k] = *(const LAS bf16x8*)(lds + PG8_SA(b, h) + aoff + m * 2048 + k * 1024); } while (0)
#define PG8_LDB(dst, b, h) do { _Pragma("unroll") for (int n = 0; n < 2; ++n) _Pragma("unroll") for (int k = 0; k < 2; ++k) dst[n][k] = *(const LAS bf16x8*)(lds + PG8_SB(b, h) + boff + n * 2048 + k * 1024); } while (0)
#define PG8_MMA(ai, bj, At, Bt) do { __builtin_amdgcn_s_setprio(1); _Pragma("unroll") for (int m = 0; m < 4; ++m) _Pragma("unroll") for (int n = 0; n < 2; ++n) _Pragma("unroll") for (int k = 0; k < 2; ++k) \
        acc[ai][bj][m][n] = __builtin_amdgcn_mfma_f32_16x16x32_bf16(Bt[n][k], At[m][k], acc[ai][bj][m][n], 0, 0, 0); __builtin_amdgcn_s_setprio(0); } while (0)
#define PG8_WAIT_V(n) asm volatile("s_waitcnt vmcnt(" #n ")" ::: "memory")
#define PG8_WAIT_L(n) asm volatile("s_waitcnt lgkmcnt(" #n ")" ::: "memory")
#define PG8_BAR __builtin_amdgcn_s_barrier()
#define PG8_SCHED __builtin_amdgcn_sched_barrier(0)
    Unit cur, nxt; int ui = 0;
    if (!S.next(0, cur)) return;
    RsCtx rc; rc.t = (const LAS float*)(lds + 132096); rc.p0 = -1; rc.p1 = -1; rc.ssq_x = nullptr;
    if constexpr (Epi::RS16 != 0) {
        rc.ssq_x = E.ssq_x; Unit uu;
        for (int i = 0; S.next(i, uu); ++i) { if (!Epi::rs_kind(uu.kind)) continue; const int key = uu.pm; if (key != rc.p0 && key != rc.p1) { if (rc.p0 < 0) rc.p0 = key; else if (rc.p1 < 0) rc.p1 = key; } }
        const int key = tid < 256 ? rc.p0 : rc.p1;
        if (key >= 0) ((LAS float*)(lds + 132096))[tid] = row_rs16(E.ssq_x, key * 256 + (tid & 255));
        asm volatile("s_waitcnt vmcnt(0) lgkmcnt(0)" ::: "memory"); __builtin_amdgcn_s_barrier(); asm volatile("" ::: "memory");
    }
    f32x4 acc[2][2][4][2];
#pragma unroll
    for (int a = 0; a < 2; ++a)
#pragma unroll
        for (int b = 0; b < 2; ++b)
#pragma unroll
            for (int m = 0; m < 4; ++m)
#pragma unroll
                for (int n = 0; n < 2; ++n) acc[a][b][m][n] = (f32x4){0.f, 0.f, 0.f, 0.f};
    bf16x8 At[4][2], B0[2][2], B1[2][2];
    Gemm gc = GS.get(cur.kind);
    int ntc = gc.K / BK; asm volatile("" : "+s"(ntc));
    unsigned vAc, vBc; PGM_VOFF(vAc, vBc, gc);
    size_t hAc = (size_t)HALF * gc.lda * 2, hBc = (size_t)HALF * gc.ldb * 2;
    const char* cA = (const char*)gc.A + (size_t)cur.pm * 2 * hAc; const char* cB = (const char*)gc.Bt + (size_t)cur.pn * 2 * hBc;
    PG8_STAGE(PG8_SB(0, 0), cB, vBc, hBc / 2); PG8_STAGE(PG8_SB(0, 1), cB + hBc, vBc, hBc / 2); PG8_STAGE(PG8_SA(0, 0), cA, vAc, hAc / 2); PG8_STAGE(PG8_SA(0, 1), cA + hAc, vAc, hAc / 2);
    if (wr == 1) PG8_BAR;
    PG8_WAIT_V(2); PG8_BAR;
    PG8_STAGE(PG8_SB(1, 0), cB + kstep, vBc, hBc / 2); PG8_STAGE(PG8_SA(1, 0), cA + kstep, vAc, hAc / 2); PG8_STAGE(PG8_SB(1, 1), cB + hBc + kstep, vBc, hBc / 2);
    PG8_WAIT_V(6); PG8_BAR;
    for (;;) {
        const bool has_next = S.next(ui + 1, nxt);
        if (!has_next) nxt = cur;
        const Gemm gn = GS.get(nxt.kind);
        unsigned vAn, vBn; PGM_VOFF(vAn, vBn, gn);
        const size_t hAn = (size_t)HALF * gn.lda * 2, hBn = (size_t)HALF * gn.ldb * 2;
        const char* nA = (const char*)gn.A + (size_t)nxt.pm * 2 * hAn; const char* nB = (const char*)gn.Bt + (size_t)nxt.pn * 2 * hBn;
        for (int t = 0; t < ntc; t += 2) {
            const bool last = (t == ntc - 2);
            const char* a1 = cA + (size_t)(t + 1) * kstep;
            const char* a2 = last ? nA : cA + (size_t)(t + 2) * kstep; const char* b2 = last ? nB : cB + (size_t)(t + 2) * kstep;
            const char* a3 = a2 + kstep; const char* b3 = b2 + kstep;
            const unsigned vA2 = last ? vAn : vAc, vB2 = last ? vBn : vBc;
            const size_t hA2 = last ? hAn : hAc, hB2 = last ? hBn : hBc;
            PG8_LDB(B0, 0, 0); PG8_LDB(B1, 0, 1); PG8_SCHED; PG8_LDA(At, 0, 0); PG8_STAGE(PG8_SA(1, 1), a1 + hAc, vAc, hAc / 2);
            PG8_WAIT_V(8); PG8_WAIT_L(0); PG8_BAR; PG8_MMA(0, 0, At, B0); PG8_MMA(0, 1, At, B1); PG8_BAR; PG8_SCHED;
            PG8_LDA(At, 0, 1); PG8_STAGE(PG8_SB(0, 0), b2, vB2, hB2 / 2); PG8_STAGE(PG8_SB(0, 1), b2 + hB2, vB2, hB2 / 2); PG8_STAGE(PG8_SA(0, 0), a2, vA2, hA2 / 2);
            PG8_WAIT_V(8); PG8_WAIT_L(0); PG8_BAR; PG8_MMA(1, 0, At, B0); PG8_MMA(1, 1, At, B1); PG8_BAR; PG8_SCHED;
            PG8_LDB(B0, 1, 0); PG8_LDB(B1, 1, 1); PG8_SCHED; PG8_LDA(At, 1, 0); PG8_STAGE(PG8_SA(0, 1), a2 + hA2, vA2, hA2 / 2);
            PG8_WAIT_V(8); PG8_WAIT_L(0); PG8_BAR; PG8_MMA(0, 0, At, B0); PG8_MMA(0, 1, At, B1); PG8_BAR; PG8_SCHED;
            PG8_LDA(At, 1, 1); PG8_STAGE(PG8_SB(1, 0), b3, vB2, hB2 / 2); PG8_STAGE(PG8_SB(1, 1), b3 + hB2, vB2, hB2 / 2); PG8_STAGE(PG8_SA(1, 0), a3, vA2, hA2 / 2);
            PG8_WAIT_V(8); PG8_WAIT_L(0); PG8_BAR; PG8_MMA(1, 0, At, B0); PG8_MMA(1, 1, At, B1); PG8_BAR; PG8_SCHED;
        }
        if (wr == 0) PG8_BAR;
        E(acc, cur, wr, wc, fr, fq, rc);
        if (!has_next) break;
#pragma unroll
        for (int a = 0; a < 2; ++a)
#pragma unroll
            for (int b = 0; b < 2; ++b)
#pragma unroll
                for (int m = 0; m < 4; ++m)
#pragma unroll
                    for (int n = 0; n < 2; ++n) acc[a][b][m][n] = (f32x4){0.f, 0.f, 0.f, 0.f};
        cur = nxt; cA = nA; cB = nB; vAc = vAn; vBc = vBn; hAc = hAn; hBc = hBn; ntc = gn.K / BK; asm volatile("" : "+s"(ntc)); ++ui;
        if (wr == 1) PG8_BAR;
    }
    PG8_WAIT_V(0);
    PG8_BAR;
#undef PGM_VOFF
#undef PG8_SA
#undef PG8_SB
#undef PG8_STAGE
#undef PG8_LDA
#undef PG8_LDB
#undef PG8_MMA
#undef PG8_WAIT_V
#undef PG8_WAIT_L
#undef PG8_BAR
#undef PG8_SCHED
}
}
using pg8::Unit;
typedef f32x4 Acc[2][2][4][2];


#define EPI_ROW(u, ai, wr, m, fr) ((u).pm * 256 + (ai) * 128 + (wr) * 64 + (m) * 16 + (fr))
struct EpiSwiGLU {
    static constexpr int RS16 = 1;
    bf16_t* O; const float* ssq_x;
    __device__ __forceinline__ void operator()(const Acc& acc, const Unit& u, int wr, int wc, int fr, int fq, const RsCtx& rc) const {
        const int col = u.pn * 128 + wc * 32 + 8 * fq;
#pragma unroll
        for (int ai = 0; ai < 2; ++ai)
#pragma unroll
            for (int m = 0; m < 4; ++m) { const int row = EPI_ROW(u, ai, wr, m, fr); const float rs = rc.get(u.pm, ai * 128 + wr * 64 + m * 16 + fr, row);
                f32x4 a0 = acc[ai][0][m][0] * rs, a1 = acc[ai][0][m][1] * rs; const f32x4 b0 = acc[ai][1][m][0] * rs, b1 = acc[ai][1][m][1] * rs;
#pragma unroll
                for (int e = 0; e < 4; ++e) { a0[e] = a0[e] * fast_sigmoid(a0[e]) * b0[e]; a1[e] = a1[e] * fast_sigmoid(a1[e]) * b1[e]; }
                *(u32x4*)(O + (size_t)row * FF + col) = pack8(a0, a1);
                if (m == 3) asm volatile("" ::: "memory"); }
    }
};
struct EpiResid {
    static constexpr int RS16 = 0;
    float* X; bf16_t* XB; float* ssq_x; float alpha;
    __device__ __forceinline__ void operator()(const Acc& acc, const Unit& u, int wr, int wc, int fr, int fq, const RsCtx& rc) const {
#pragma unroll
        for (int ai = 0; ai < 2; ++ai)
#pragma unroll
            for (int m = 0; m < 4; ++m) { const int row = EPI_ROW(u, ai, wr, m, fr); float s = 0.f;
#pragma unroll
                for (int bj = 0; bj < 2; ++bj) { const size_t off = (size_t)row * DM + u.pn * 256 + bj * 128 + wc * 32 + 8 * fq;
                    f32x4 x0, x1; unpack8(*(const u32x4*)(XB + off), x0, x1);
                    x0 = x0 + acc[ai][bj][m][0] * alpha; x1 = x1 + acc[ai][bj][m][1] * alpha;
                    *(u32x4*)(XB + off) = pack8(x0, x1);
#pragma unroll
                    for (int e = 0; e < 4; ++e) s += x0[e] * x0[e] + x1[e] * x1[e]; }
                s += __shfl_xor(s, 16); s += __shfl_xor(s, 32);
                if (fq == 0) ssq_x[(size_t)row * 16 + u.pn * 4 + wc] = s;
                if (m == 3) asm volatile("" ::: "memory"); }
    }
};
struct EpiWin {
    static constexpr int RS16 = 1;
    bf16_t *LAT, *CONVB, *CONVZ, *SWAQK; float *ssq_q, *ssq_kv; const float *TABM, *TABS; const float* ssq_x;
    __device__ __forceinline__ void operator()(const Acc& acc, const Unit& u, int wr, int wc, int fr, int fq, const RsCtx& rc) const {
        const int pn = u.pn, cw = wc * 32 + 8 * fq;
#pragma unroll
        for (int ai = 0; ai < 2; ++ai)
#pragma unroll
            for (int m = 0; m < 4; ++m) { const int row = EPI_ROW(u, ai, wr, m, fr);
                const float rs = rc.get(u.pm, ai * 128 + wr * 64 + m * 16 + fr, row);
                f32x4 a0 = acc[ai][0][m][0] * rs, a1 = acc[ai][0][m][1] * rs, b0 = acc[ai][1][m][0] * rs, b1 = acc[ai][1][m][1] * rs;
                if (pn == 0) {
                    float s = 0.f;
#pragma unroll
                    for (int e = 0; e < 4; ++e) s += a0[e] * a0[e] + a1[e] * a1[e] + b0[e] * b0[e] + b1[e] * b1[e];
                    s += __shfl_xor(s, 16); s += __shfl_xor(s, 32);
                    if (fq == 0) ssq_q[row * 4 + wc] = s;
                    *(u32x4*)(LAT + (size_t)row * 512 + cw) = pack8(a0, a1); *(u32x4*)(LAT + (size_t)row * 512 + 128 + cw) = pack8(b0, b1);
                } else if (pn == 1) {
                    float s = 0.f;
#pragma unroll
                    for (int e = 0; e < 4; ++e) s += a0[e] * a0[e] + a1[e] * a1[e];
                    s += __shfl_xor(s, 16); s += __shfl_xor(s, 32);
                    if (fq == 0) ssq_kv[row * 4 + wc] = s;
                    *(u32x4*)(LAT + (size_t)row * 512 + 256 + cw) = pack8(a0, a1);
                    if (wc == 0) { rope8(b0, b1, TABM + ((size_t)tok_pos(row) * 16 + 4 * fq) * 2); *(u32x4*)(LAT + (size_t)row * 512 + 384 + cw) = pack8(b0, b1); }
                } else if (pn < 4) {
                    bf16_t* p = CONVB + (size_t)row * 512 + (pn - 2) * 256 + cw;
                    *(u32x4*)p = pack8(a0, a1); *(u32x4*)(p + 128) = pack8(b0, b1);
                } else if (pn < 8) {
                    *(u32x4*)(CONVZ + (size_t)row * 512 + (pn - 4) * 128 + cw) = pack8(a0 * b0, a1 * b1);
                } else if (pn < 10) {
                    const int c = (pn - 8) * 256 + cw; const float* tb = TABS + (size_t)tok_pos(row) * 64;
                    rope8(a0, a1, tb + (c & 63)); rope8(b0, b1, tb + ((c + 128) & 63));
                    const float sc = 0.125f * LOG2E;
                    *(u32x4*)(SWAQK + (size_t)row * 768 + c) = pack8(a0 * sc, a1 * sc); *(u32x4*)(SWAQK + (size_t)row * 768 + c + 128) = pack8(b0 * sc, b1 * sc);
                } else {
                    rope8(a0, a1, TABS + (size_t)tok_pos(row) * 64 + (cw & 63));
                    *(u32x4*)(SWAQK + (size_t)row * 768 + 512 + cw) = pack8(a0, a1);
                }
                if (m == 3) asm volatile("" ::: "memory");
            }
    }
};
struct EpiQ {
    static constexpr int RS16 = 0;
    bf16_t* Q; const float* ssq_q; const float* TABM;
    __device__ __forceinline__ void operator()(const Acc& acc, const Unit& u, int wr, int wc, int fr, int fq, const RsCtx& rc) const {
        const float C2 = 0.10206207261596577f * LOG2E;
#pragma unroll
        for (int ai = 0; ai < 2; ++ai)
#pragma unroll
            for (int m = 0; m < 4; ++m) { const int row = EPI_ROW(u, ai, wr, m, fr);
                const f32x4 sp = *(const f32x4*)(ssq_q + row * 4); const float rs = rsqrtf(((sp[0] + sp[1]) + (sp[2] + sp[3])) * (1.0f / 256.0f) + EPS) * C2; const float* tb = TABM + (size_t)tok_pos(row) * 32;
#pragma unroll
                for (int bj = 0; bj < 2; ++bj) { const int c = u.pn * 256 + bj * 128 + wc * 32 + 8 * fq; const int d = c % 96;
                    f32x4 v0 = acc[ai][bj][m][0] * rs, v1 = acc[ai][bj][m][1] * rs;
                    if (d >= 64) rope8(v0, v1, tb + (d - 64));
                    *(u32x4*)(Q + (size_t)row * 768 + c) = pack8(v0, v1); }
                if (m == 3) asm volatile("" ::: "memory"); }
    }
};
struct EpiRowScale {
    static constexpr int RS16 = 0;
    bf16_t* O; const float* ssq;
    __device__ __forceinline__ void operator()(const Acc& acc, const Unit& u, int wr, int wc, int fr, int fq, const RsCtx& rc) const {
#pragma unroll
        for (int ai = 0; ai < 2; ++ai)
#pragma unroll
            for (int m = 0; m < 4; ++m) { const int row = EPI_ROW(u, ai, wr, m, fr); const f32x4 sp = *(const f32x4*)(ssq + row * 4); const float rs = rsqrtf(((sp[0] + sp[1]) + (sp[2] + sp[3])) * (1.0f / 128.0f) + EPS);
#pragma unroll
                for (int bj = 0; bj < 2; ++bj) *(u32x4*)(O + (size_t)row * 512 + u.pn * 256 + bj * 128 + wc * 32 + 8 * fq) = pack8(acc[ai][bj][m][0] * rs, acc[ai][bj][m][1] * rs);
                if (m == 3) asm volatile("" ::: "memory"); }
    }
};
struct EpiColScaleT {
    static constexpr int RS16 = 0;
    bf16_t* O; const float* ssq; int nrows; bool x16;
    __device__ __forceinline__ void operator()(const Acc& acc, const Unit& u, int wr, int wc, int fr, int fq, const RsCtx& rc) const {
#pragma unroll
        for (int bj = 0; bj < 2; ++bj) { const int c = u.pn * 256 + bj * 128 + wc * 32 + 8 * fq;
            f32x4 r0 = (f32x4){1.f, 1.f, 1.f, 1.f}, r1 = r0;
            if (x16) {
#pragma unroll
                for (int e = 0; e < 4; ++e) { r0[e] = row_rs16(ssq, c + e); r1[e] = row_rs16(ssq, c + 4 + e); }
            } else {
#pragma unroll
                for (int e = 0; e < 4; ++e) { const f32x4 sa = *(const f32x4*)(ssq + (c + e) * 4), sb = *(const f32x4*)(ssq + (c + 4 + e) * 4);
                    r0[e] = rsqrtf(((sa[0] + sa[1]) + (sa[2] + sa[3])) * (1.0f / 128.0f) + EPS); r1[e] = rsqrtf(((sb[0] + sb[1]) + (sb[2] + sb[3])) * (1.0f / 128.0f) + EPS); } }
#pragma unroll
            for (int ai = 0; ai < 2; ++ai)
#pragma unroll
                for (int m = 0; m < 4; ++m) { const int row = EPI_ROW(u, ai, wr, m, fr);
                    if (row < nrows) *(u32x4*)(O + (size_t)row * T + c) = pack8(acc[ai][bj][m][0] * r0, acc[ai][bj][m][1] * r1); } }
    }
};
struct EpiGate {
    static constexpr int RS16 = 1;
    unsigned char* G; const float* ssq_x;
    __device__ __forceinline__ void operator()(const Acc& acc, const Unit& u, int wr, int wc, int fr, int fq, const RsCtx& rc) const {
#pragma unroll
        for (int ai = 0; ai < 2; ++ai)
#pragma unroll
            for (int m = 0; m < 4; ++m) { const int row = EPI_ROW(u, ai, wr, m, fr); const float rs = rc.get(u.pm, ai * 128 + wr * 64 + m * 16 + fr, row);
#pragma unroll
                for (int bj = 0; bj < 2; ++bj) { f32x4 v0 = acc[ai][bj][m][0] * rs, v1 = acc[ai][bj][m][1] * rs;
#pragma unroll
                    for (int e = 0; e < 4; ++e) { v0[e] = __builtin_rintf(fast_sigmoid(v0[e]) * 255.0f); v1[e] = __builtin_rintf(fast_sigmoid(v1[e]) * 255.0f); }
                    u32x2 w; w.x = 0u; w.y = 0u;
                    w.x = __builtin_amdgcn_cvt_pk_u8_f32(v0[0], 0, w.x); w.x = __builtin_amdgcn_cvt_pk_u8_f32(v0[1], 1, w.x); w.x = __builtin_amdgcn_cvt_pk_u8_f32(v0[2], 2, w.x); w.x = __builtin_amdgcn_cvt_pk_u8_f32(v0[3], 3, w.x);
                    w.y = __builtin_amdgcn_cvt_pk_u8_f32(v1[0], 0, w.y); w.y = __builtin_amdgcn_cvt_pk_u8_f32(v1[1], 1, w.y); w.y = __builtin_amdgcn_cvt_pk_u8_f32(v1[2], 2, w.y); w.y = __builtin_amdgcn_cvt_pk_u8_f32(v1[3], 3, w.y);
                    *(u32x2*)(G + (size_t)row * DM + u.pn * 256 + bj * 128 + wc * 32 + 8 * fq) = w; } }
    }
};
struct EpiMerge {
    static constexpr int RS16 = 0;
    const unsigned char* G; bf16_t* Mg; bool first;
    __device__ __forceinline__ void operator()(const Acc& acc, const Unit& u, int wr, int wc, int fr, int fq, const RsCtx& rc) const {
#pragma unroll
        for (int ai = 0; ai < 2; ++ai)
#pragma unroll
            for (int m = 0; m < 4; ++m) { const int row = EPI_ROW(u, ai, wr, m, fr);
#pragma unroll
                for (int bj = 0; bj < 2; ++bj) { const size_t off = (size_t)row * DM + u.pn * 256 + bj * 128 + wc * 32 + 8 * fq;
                    const u32x2 gw = *(const u32x2*)(G + off); const float k255 = 1.0f / 255.0f;
                    const f32x4 g0 = (f32x4){(float)(gw.x & 0xffu), (float)((gw.x >> 8) & 0xffu), (float)((gw.x >> 16) & 0xffu), (float)(gw.x >> 24)} * k255;
                    const f32x4 g1 = (f32x4){(float)(gw.y & 0xffu), (float)((gw.y >> 8) & 0xffu), (float)((gw.y >> 16) & 0xffu), (float)(gw.y >> 24)} * k255;
                    f32x4 v0 = g0 * acc[ai][bj][m][0], v1 = g1 * acc[ai][bj][m][1];
                    if (!first) { f32x4 o0, o1; unpack8(*(const u32x4*)(Mg + off), o0, o1); v0 = v0 + o0; v1 = v1 + o1; }
                    *(u32x4*)(Mg + off) = pack8(v0, v1); }
                if (m == 3) asm volatile("" ::: "memory"); }
    }
};

struct UnitMajor6 {
    pg8::StaticOrder S;
    __device__ __forceinline__ bool next(int i, Unit& u) const { const int j = i / 6; if (!S.next(j, u)) return false; u.kind = i - 6 * j; return true; }
};
struct GSelMerge { unsigned char* ws; unsigned char* Wb;
    __device__ __forceinline__ pg8::Gemm get(int kind) const { const int b = kind >> 1; pg8::Gemm g; g.M = T; g.N = DM;
        if (kind & 1) { const size_t oa = b == 0 ? WS_CONVB : (b == 1 ? WS_CB : WS_CONVZ); g.A = (const bf16_t*)(ws + oa); g.Bt = (const bf16_t*)(Wb + O_WAO + (size_t)b * 1048576); g.K = 512; g.lda = 512; g.ldb = 512; }
        else { g.A = (const bf16_t*)(ws + WS_HB); g.Bt = (const bf16_t*)(Wb + O_WG) + (size_t)b * 1024 * 1024; g.K = DM; g.lda = DM; g.ldb = DM; }
        return g; } };
struct EpiGateMerge {
    static constexpr int RS16 = 1;
    __device__ static __forceinline__ bool rs_kind(int kind) { return (kind & 1) == 0; }
    unsigned char* G; bf16_t* Mg; const float* ssq_x;
    __device__ __forceinline__ void operator()(const Acc& acc, const Unit& u, int wr, int wc, int fr, int fq, const RsCtx& rc) const {
        int fr2 = fr, fq2 = fq; asm volatile("" : "+v"(fr2), "+v"(fq2));
        if (u.kind & 1) { EpiMerge m; m.G = G; m.Mg = Mg; m.first = (u.kind == 1); m(acc, u, wr, wc, fr2, fq2, rc); }
        else { EpiGate g; g.G = G; g.ssq_x = ssq_x; g(acc, u, wr, wc, fr2, fq2, rc); }
    }
};

__device__ __forceinline__ bf16_t* wdst(int kind, int n, unsigned char* Wb) {
    switch (kind) {
    case 0: case 2: { const int up = n >= FF, j = up ? n - FF : n; const int row = 256 * (j >> 7) + (j & 127) + (up ? 128 : 0); return (bf16_t*)(Wb + (kind == 0 ? O_GU1 : O_GU2)) + (size_t)row * 1024; }
    case 1: case 3: return (bf16_t*)(Wb + (kind == 1 ? O_DN1 : O_DN2)) + (size_t)n * FF;
    case 4: {
        bf16_t* WIN = (bf16_t*)(Wb + O_WIN); int row;
        if (n < 384) row = n;
        else if (n < 416) { const int c = n - 384; row = 384 + 2 * (c & 15) + (c >> 4); }
        else if (n < 928) row = 512 + (n - 416);
        else if (n < 1440) { const int c = n - 928; row = 1024 + 256 * (c >> 7) + (c & 127); }
        else if (n < 1952) { const int c = n - 1440; row = 1024 + 256 * (c >> 7) + 128 + (c & 127); }
        else if (n < 2464) { const int c = n - 1952, hd = c >> 6, d = c & 63; row = 2048 + hd * 64 + 2 * (d & 31) + (d >> 5); }
        else if (n < 2592) { const int c = n - 2464, hd = c >> 6, d = c & 63; row = 2560 + hd * 64 + 2 * (d & 31) + (d >> 5); }
        else if (n < 2720) return (bf16_t*)(Wb + O_WSV) + (size_t)(n - 2592) * 1024;
        else return (bf16_t*)(Wb + O_WG) + (size_t)(n - 2720) * 1024;
        return WIN + (size_t)row * 1024; }
    case 5: { const int hd = n / 96, d = n - hd * 96; int row = n; if (d >= 64) { const int c = d - 64; row = hd * 96 + 64 + 2 * (c & 15) + (c >> 4); } return (bf16_t*)(Wb + O_WUQ) + (size_t)row * 256; }
    case 6: { const int hd = n >> 7, d = n & 127; return d < 64 ? (bf16_t*)(Wb + O_WUK) + (size_t)(hd * 64 + d) * 128 : (bf16_t*)(Wb + O_WUV) + (size_t)(hd * 64 + d - 64) * 128; }
    case 7: return (bf16_t*)(Wb + O_WAO) + (size_t)n * 512;
    case 8: return (bf16_t*)(Wb + O_WBO) + (size_t)n * 512;
    case 9: return (bf16_t*)(Wb + O_WCO) + (size_t)n * 512;
    default: return (bf16_t*)(Wb + O_WO) + (size_t)n * 1024;
    }
}
__device__ __forceinline__ void conv_item(const float* W, int K, int N, int kind, int item, const float* gain, unsigned char* Wb, float* scr, int lane) {
    const int nblk = N / 32, kb = item / nblk, nb = item - kb * nblk, k0 = 64 * kb, n0 = 32 * nb;
    float wv_[32];
#pragma unroll
    for (int i = 0; i < 32; ++i) wv_[i] = W[(size_t)(k0 + 2 * i + (lane >> 5)) * N + n0 + (lane & 31)];
#pragma unroll
    for (int i = 0; i < 32; ++i) scr[(2 * i + (lane >> 5)) * 33 + (lane & 31)] = wv_[i];
    __builtin_amdgcn_s_waitcnt(0); asm volatile("" ::: "memory");
    const int c = lane & 7; float gg[8];
#pragma unroll
    for (int e = 0; e < 8; ++e) gg[e] = gain ? gain[k0 + 8 * c + e] : 1.0f;
#pragma unroll
    for (int j = 0; j < 4; ++j) { const int n = (lane >> 3) + 8 * j; const float* s = scr + (8 * c) * 33 + n;
        u32x4 o; o.x = pk2(s[0] * gg[0], s[33] * gg[1]); o.y = pk2(s[2 * 33] * gg[2], s[3 * 33] * gg[3]); o.z = pk2(s[4 * 33] * gg[4], s[5 * 33] * gg[5]); o.w = pk2(s[6 * 33] * gg[6], s[7 * 33] * gg[7]);
        *(u32x4*)(wdst(kind, n0 + n, Wb) + k0 + 8 * c) = o; }
    __builtin_amdgcn_s_waitcnt(0); asm volatile("" ::: "memory");
}

constexpr int AT_KB = 12 * 1024, AT_BUF = AT_KB + 8 * 1024;
#define AT_SB() __builtin_amdgcn_sched_barrier(0)
template <bool SWA>
__device__ __forceinline__ void attn_unit(unsigned char* lds, LAS unsigned char* ldsl, const bf16_t* Qrow, const bf16_t* Kp, int ldk, const bf16_t* Kr, const bf16_t* Vt,
                                          int ntiles, float m_init, float l_init, int qrel, bf16_t* Owave, const int tid) {
    constexpr int ND = SWA ? 4 : 6;
    constexpr float THR = 6.0f;
    const int lane = tid & 63, l32 = lane & 31, hi = lane >> 5; const int wv = __builtin_amdgcn_readfirstlane(tid >> 6);
    bf16x8 qf[ND];
#pragma unroll
    for (int d0 = 0; d0 < ND; ++d0) qf[d0] = *(const bf16x8*)(Qrow + 16 * d0 + 8 * hi);
    const int pkey = (lane & ~12) | ((lane & 4) << 1) | ((lane & 8) >> 1);
    const int koff = pkey * ldk + 8 * wv, voff = lane * T + 8 * wv, roff = pkey * 512 + 8 * (wv & 3);
    const bool do_r = (!SWA) && wv < 4;
    const int kfo = hi * 1024 + l32 * 16, vfo = AT_KB + hi * 1024 + l32 * 16;
#define AT_GLOAD(tt, boff) do { \
        __builtin_amdgcn_global_load_lds((const unsigned*)((Kp + (size_t)(tt) * 64 * ldk) + koff), (LAS unsigned*)(ldsl + (boff) + wv * 1024), 16, 0, 0); \
        __builtin_amdgcn_global_load_lds((const unsigned*)((Vt + (tt) * 64) + voff), (LAS unsigned*)(ldsl + (boff) + AT_KB + wv * 1024), 16, 0, 0); \
        if (do_r) __builtin_amdgcn_global_load_lds((const unsigned*)((Kr + (size_t)(tt) * 64 * 512) + roff), (LAS unsigned*)(ldsl + (boff) + 8192 + wv * 1024), 16, 0, 0); } while (0)
    AT_GLOAD(0, 0); AT_GLOAD(1, AT_BUF);
    asm volatile("s_waitcnt vmcnt(0)" ::: "memory");
    __syncthreads();
    f32x16 o0, o1, negm;
    float mref = SWA ? m_init : 0.f, lrun = l_init;
#pragma unroll
    for (int r = 0; r < 16; ++r) { o0[r] = 0.f; o1[r] = 0.f; negm[r] = -mref; }
    f32x16 sA0, sA1, sB0, sB1;
#define AT_MASK(S0, S1, tt) do { if (SWA) { const int kb_ = (tt) * 64 + 8 * hi - qrel; _Pragma("unroll") for (int r = 0; r < 16; ++r) { const int d_ = kb_ + 16 * (r >> 3) + (r & 7); \
        if (d_ < -128 || d_ > 128) S0[r] = -1e30f; if (d_ + 32 < -128 || d_ + 32 > 128) S1[r] = -1e30f; } } } while (0)
    {
        const unsigned char* Bn = lds;
        sA0 = __builtin_amdgcn_mfma_f32_32x32x16_bf16(*(const bf16x8*)(Bn + kfo), qf[0], negm, 0, 0, 0);
        sA1 = __builtin_amdgcn_mfma_f32_32x32x16_bf16(*(const bf16x8*)(Bn + kfo + 512), qf[0], negm, 0, 0, 0);
#pragma unroll
        for (int d0 = 1; d0 < ND; ++d0) { sA0 = __builtin_amdgcn_mfma_f32_32x32x16_bf16(*(const bf16x8*)(Bn + kfo + 2048 * d0), qf[d0], sA0, 0, 0, 0);
            sA1 = __builtin_amdgcn_mfma_f32_32x32x16_bf16(*(const bf16x8*)(Bn + kfo + 512 + 2048 * d0), qf[d0], sA1, 0, 0, 0); }
        AT_MASK(sA0, sA1, 0);
    }
    int bt = 0, bn = AT_BUF, bw = 2 * AT_BUF;
#define AT_STEP(tt, SC0, SC1, SN0, SN1, FULL) do { \
        const bool more2_ = ((tt) + 2) < ntiles; \
        if (more2_) AT_GLOAD((tt) + 2, bw); \
        float mx_; \
        { float ma = __builtin_fmaxf(__builtin_fmaxf(SC0[0], SC0[1]), SC1[0]), mb = __builtin_fmaxf(__builtin_fmaxf(SC0[2], SC0[3]), SC1[1]); \
          ma = __builtin_fmaxf(__builtin_fmaxf(ma, SC1[2]), SC1[3]); \
          _Pragma("unroll") for (int r = 4; r < 16; r += 4) { ma = __builtin_fmaxf(__builtin_fmaxf(ma, SC0[r]), SC0[r + 1]); mb = __builtin_fmaxf(__builtin_fmaxf(mb, SC0[r + 2]), SC0[r + 3]); \
              ma = __builtin_fmaxf(__builtin_fmaxf(ma, SC1[r]), SC1[r + 1]); mb = __builtin_fmaxf(__builtin_fmaxf(mb, SC1[r + 2]), SC1[r + 3]); } \
          mx_ = __builtin_fmaxf(ma, mb); \
          auto rr = __builtin_amdgcn_permlane32_swap(__float_as_uint(mx_), __float_as_uint(mx_), false, false); mx_ = __builtin_fmaxf(__uint_as_float(rr[0]), __uint_as_float(rr[1])); } \
        const bool reset_ = (!SWA) && (tt) == 0; \
        if (__any(reset_ || mx_ > THR)) { \
            const float dl = reset_ ? mx_ : __builtin_fmaxf(mx_, 0.f); \
            mref += dl; const float alpha = __builtin_amdgcn_exp2f(-dl); lrun *= alpha; \
            _Pragma("unroll") for (int r = 0; r < 16; ++r) { SC0[r] -= dl; SC1[r] -= dl; o0[r] *= alpha; o1[r] *= alpha; negm[r] = -mref; } \
        } \
        AT_SB(); \
        const unsigned char* Bn_ = lds + bn; const unsigned char* Bt_ = lds + bt; \
        if (FULL) { \
            SN0 = __builtin_amdgcn_mfma_f32_32x32x16_bf16(*(const bf16x8*)(Bn_ + kfo), qf[0], negm, 0, 0, 0); \
            SN1 = __builtin_amdgcn_mfma_f32_32x32x16_bf16(*(const bf16x8*)(Bn_ + kfo + 512), qf[0], negm, 0, 0, 0); \
            _Pragma("unroll") for (int d0 = 1; d0 < ND; ++d0) { SN0 = __builtin_amdgcn_mfma_f32_32x32x16_bf16(*(const bf16x8*)(Bn_ + kfo + 2048 * d0), qf[d0], SN0, 0, 0, 0); \
                SN1 = __builtin_amdgcn_mfma_f32_32x32x16_bf16(*(const bf16x8*)(Bn_ + kfo + 512 + 2048 * d0), qf[d0], SN1, 0, 0, 0); } \
        } \
        float ls_ = 0.f; \
        _Pragma("unroll") for (int r = 0; r < 16; ++r) { SC0[r] = __builtin_amdgcn_exp2f(SC0[r]); SC1[r] = __builtin_amdgcn_exp2f(SC1[r]); ls_ += SC0[r] + SC1[r]; } \
        lrun += ls_; \
        bf16x8 pf_[4]; \
        { u32x4 w; \
          w.x = pk2(SC0[0], SC0[1]); w.y = pk2(SC0[2], SC0[3]); w.z = pk2(SC0[4], SC0[5]); w.w = pk2(SC0[6], SC0[7]); pf_[0] = __builtin_bit_cast(bf16x8, w); \
          w.x = pk2(SC0[8], SC0[9]); w.y = pk2(SC0[10], SC0[11]); w.z = pk2(SC0[12], SC0[13]); w.w = pk2(SC0[14], SC0[15]); pf_[1] = __builtin_bit_cast(bf16x8, w); \
          w.x = pk2(SC1[0], SC1[1]); w.y = pk2(SC1[2], SC1[3]); w.z = pk2(SC1[4], SC1[5]); w.w = pk2(SC1[6], SC1[7]); pf_[2] = __builtin_bit_cast(bf16x8, w); \
          w.x = pk2(SC1[8], SC1[9]); w.y = pk2(SC1[10], SC1[11]); w.z = pk2(SC1[12], SC1[13]); w.w = pk2(SC1[14], SC1[15]); pf_[3] = __builtin_bit_cast(bf16x8, w); } \
        _Pragma("unroll") for (int g = 0; g < 4; ++g) { o0 = __builtin_amdgcn_mfma_f32_32x32x16_bf16(*(const bf16x8*)(Bt_ + vfo + 2048 * g), pf_[g], o0, 0, 0, 0); \
            o1 = __builtin_amdgcn_mfma_f32_32x32x16_bf16(*(const bf16x8*)(Bt_ + vfo + 512 + 2048 * g), pf_[g], o1, 0, 0, 0); } \
        if (FULL) { __builtin_amdgcn_sched_group_barrier(0x100, 4, 0); \
            _Pragma("unroll") for (int i_ = 0; i_ < 2 * ND; ++i_) { __builtin_amdgcn_sched_group_barrier(0x008, 1, 0); __builtin_amdgcn_sched_group_barrier(0x100, 2, 0); __builtin_amdgcn_sched_group_barrier(0x402, SWA ? 6 : 4, 0); } \
            _Pragma("unroll") for (int i_ = 0; i_ < 8; ++i_) { __builtin_amdgcn_sched_group_barrier(0x008, 1, 0); __builtin_amdgcn_sched_group_barrier(0x402, 6, 0); } } \
        AT_SB(); \
        if (FULL) AT_MASK(SN0, SN1, (tt) + 1); \
        asm volatile("s_waitcnt vmcnt(0)" ::: "memory"); \
        __syncthreads(); \
        { const int t_ = bt; bt = bn; bn = bw; bw = t_; } \
    } while (0)
    int t = 0;
    if (wv >= 4) __builtin_amdgcn_s_setprio(1);
    for (; t < ntiles - 2; t += 2) { AT_STEP(t, sA0, sA1, sB0, sB1, true); AT_STEP(t + 1, sB0, sB1, sA0, sA1, true); }
    AT_STEP(t, sA0, sA1, sB0, sB1, true);
    AT_STEP(t + 1, sB0, sB1, sA0, sA1, false);
    if (wv >= 4) __builtin_amdgcn_s_setprio(0);
#undef AT_STEP
#undef AT_MASK
#undef AT_GLOAD
    { auto rr = __builtin_amdgcn_permlane32_swap(__float_as_uint(lrun), __float_as_uint(lrun), false, false); lrun = __uint_as_float(rr[0]) + __uint_as_float(rr[1]); }
    const float inv = 1.0f / lrun;
    int tl2 = tid; asm volatile("" : "+v"(tl2));
    bf16_t* Orow = Owave + (size_t)(tl2 & 31) * 512;
#pragma unroll
    for (int rq = 0; rq < 4; ++rq) {
        u32x2 w; w.x = pk2(o0[4 * rq] * inv, o0[4 * rq + 1] * inv); w.y = pk2(o0[4 * rq + 2] * inv, o0[4 * rq + 3] * inv);
        *(u32x2*)(Orow + 8 * rq + 4 * (tl2 & 32 ? 1 : 0)) = w;
        w.x = pk2(o1[4 * rq] * inv, o1[4 * rq + 1] * inv); w.y = pk2(o1[4 * rq + 2] * inv, o1[4 * rq + 3] * inv);
        *(u32x2*)(Orow + 32 + 8 * rq + 4 * (tl2 & 32 ? 1 : 0)) = w;
    }
}

#define XB_TMO      128
#define XB_XCNT(j)  (256  + 64 * (j))
#define XB_XSUB(j)  (1280 + 64 * (j))
#define XB_XGEN(j)  (2304 + 64 * (j))
#define XB_TOP      3328
#define XB_TOPGEN   3392
#define XCD_BAR_WORDS 3456
#define XB_SPIN_CAP (1u << 22)
__device__ __forceinline__ unsigned xb_ld(unsigned* p)              { return __hip_atomic_load(p, __ATOMIC_RELAXED, __HIP_MEMORY_SCOPE_AGENT); }
__device__ __forceinline__ unsigned xb_add(unsigned* p, unsigned v) { return __hip_atomic_fetch_add(p, v, __ATOMIC_RELAXED, __HIP_MEMORY_SCOPE_AGENT); }
__device__ __forceinline__ unsigned xb_xcc_id() { return (unsigned)__builtin_amdgcn_s_getreg((3 << 11) | 20) & 0xFu; }
#define XB_SPIN(cond, bar) do { unsigned _sp = 0; while (cond) { __builtin_amdgcn_s_sleep(1); \
    if ((++_sp & 255u) == 0u) { if (xb_ld(&(bar)[XB_TMO])) break; if (_sp > XB_SPIN_CAP) { atomicAdd(&(bar)[XB_TMO], 1u); break; } } } } while (0)
struct XcdBarrier { unsigned* bar; unsigned x; volatile LAS unsigned* st; };
__device__ __forceinline__ XcdBarrier xcd_barrier_post(unsigned* bar, volatile LAS unsigned* st) {
    XcdBarrier b; b.bar = bar; b.x = xb_xcc_id(); b.st = st;
    if (threadIdx.x == 0) (void)xb_add(&bar[XB_XCNT(b.x)], 1u);
    return b;
}
__device__ __forceinline__ void xcd_barrier_complete(unsigned* bar, unsigned x, unsigned& nloc, unsigned& nx) {
    const unsigned G = gridDim.x * gridDim.y * gridDim.z;
    unsigned sum, cnt, mine, sp = 0u;
    for (;;) {
        sum = 0u; cnt = 0u; mine = 0u;
#pragma unroll
        for (unsigned j = 0; j < 16; ++j) { const unsigned c = xb_ld(&bar[XB_XCNT(j)]); sum += c; cnt += (c > 0u) ? 1u : 0u; mine = (j == x) ? c : mine; }
        if (sum == G) break;
        __builtin_amdgcn_s_sleep(1);
        if ((++sp & 255u) == 0u) { if (xb_ld(&bar[XB_TMO])) break; if (sp > XB_SPIN_CAP) { atomicAdd(&bar[XB_TMO], 1u); break; } }
    }
    nloc = mine > 0u ? mine : 1u; nx = cnt > 0u ? cnt : 1u;
}
__device__ __forceinline__ void xcd_barrier(const XcdBarrier& b) {
    asm volatile("s_waitcnt vmcnt(0)" ::: "memory");
    __syncthreads();
    if (threadIdx.x == 0) {
        unsigned* bar = b.bar;
        __builtin_amdgcn_s_waitcnt(0);
        unsigned nloc = b.st[0], nx = b.st[1];
        if (nloc == 0u) { xcd_barrier_complete(bar, b.x, nloc, nx); b.st[0] = nloc; b.st[1] = nx; }
        const unsigned old = xb_add(&bar[XB_XSUB(b.x)], 1u);
        const unsigned gen = old / nloc;
        if (old + 1u == (gen + 1u) * nloc) {
            __builtin_amdgcn_fence(__ATOMIC_RELEASE, "agent");
            asm volatile("s_waitcnt vmcnt(0)" ::: "memory");
            const unsigned og = xb_add(&bar[XB_TOP], 1u);
            const unsigned tg = og / nx;
            if (og + 1u == (tg + 1u) * nx) xb_add(&bar[XB_TOPGEN], 1u);
            else XB_SPIN(xb_ld(&bar[XB_TOPGEN]) == tg, bar);
            __builtin_amdgcn_fence(__ATOMIC_ACQUIRE, "agent");
            xb_add(&bar[XB_XGEN(b.x)], 1u);
            asm volatile("s_waitcnt vmcnt(0)" ::: "memory");
        } else {
            XB_SPIN(xb_ld(&bar[XB_XGEN(b.x)]) == gen, bar);
            __builtin_amdgcn_fence(__ATOMIC_ACQUIRE, "agent");
            asm volatile("s_waitcnt vmcnt(0)" ::: "memory");
        }
    }
    __syncthreads();
}

struct Args { const float* in[21]; float* out; unsigned char* ws; int ph_lo, ph_hi; };

__global__ void __launch_bounds__(512, 2) mk_fwd(Args a) {
    extern __shared__ __attribute__((aligned(16))) unsigned char lds[];
    cg::grid_group grid = cg::this_grid();
    volatile LAS unsigned* bst = (volatile LAS unsigned*)((LAS unsigned char*)lds + 131072 + 256);
    if (threadIdx.x < 2) bst[threadIdx.x] = 0u;
    __syncthreads();
    XcdBarrier xbar; xbar.bar = (unsigned*)(a.ws + WS_BAR); xbar.x = 0; xbar.st = bst;
    if (a.ph_hi - a.ph_lo > 1) xbar = xcd_barrier_post((unsigned*)(a.ws + WS_BAR), bst);
    bool dup_done = false;
#pragma nounroll
    for (int ph = a.ph_lo; ph < a.ph_hi; ++ph) {
            typedef const __attribute__((address_space(4))) Args* KArgs;
            KArgs ap = (KArgs)__builtin_amdgcn_kernarg_segment_ptr(); asm volatile("" : "+s"(ap));
            int tid = threadIdx.x; asm volatile("" : "+v"(tid));
            const int wave = __builtin_amdgcn_readfirstlane(tid >> 6);
#define LOCAL_LANE int tl_ = tid; asm volatile("" : "+v"(tl_)); const int lane = tl_ & 63
        const int G = gridDim.x, bx = blockIdx.x;
        const int vcu = (G % 8 == 0) ? (bx % 8) * (G / 8) + bx / 8 : bx;
        const int gw = vcu * 8 + wave, NGW = G * 8;
        unsigned char* ws = ap->ws; asm volatile("" : "+s"(ws));
        float* X = ap->out; asm volatile("" : "+s"(X));
        float* ssq_q = (float*)(ws + WS_SSQQ); float* ssq_kv = (float*)(ws + WS_SSQKV); float* ssq_x = (float*)(ws + WS_SSQX);
        float* TABM = (float*)(ws + WS_TABM); float* TABS = (float*)(ws + WS_TABS);
        unsigned char* Wb = ws + WS_W;
        bf16_t* HB = (bf16_t*)(ws + WS_HB); bf16_t* ACT = (bf16_t*)(ws + WS_ACT); bf16_t* LAT = (bf16_t*)(ws + WS_LAT);
        bf16_t* CONVB = (bf16_t*)(ws + WS_CONVB); bf16_t* CONVZ = (bf16_t*)(ws + WS_CONVZ); bf16_t* SWAQK = (bf16_t*)(ws + WS_SWAQK);
        bf16_t* SWAVT = (bf16_t*)(ws + WS_SWAVT); bf16_t* CB = (bf16_t*)(ws + WS_CB); bf16_t* Q = (bf16_t*)(ws + WS_Q);
        bf16_t* KNOPE = (bf16_t*)(ws + WS_KNOPE); bf16_t* VT = (bf16_t*)(ws + WS_VT); bf16_t* GB = (bf16_t*)(ws + WS_G);
        bf16_t* MERGED = (bf16_t*)(ws + WS_MERGED); bf16_t* OA = CONVB; bf16_t* OC = CONVZ;
        LAS unsigned char* ldsl = (LAS unsigned char*)lds;

        const int layer = ph / 21, sub = ph - layer * 21;
        bool sync_after = true;
        if (ph == 84) {
            if (PON(48)) {
            LOCAL_LANE;
            const float* gf = ap->in[20];
            for (int row = gw; row < T; row += NGW) {
                f32x4* xr = (f32x4*)(X + (size_t)row * DM) + lane; const u32x2* xb = (const u32x2*)(HB + (size_t)row * DM) + lane; f32x4 v[4]; float s = 0.f;
#pragma unroll
                for (int j = 0; j < 4; ++j) { const u32x2 w = xb[64 * j]; v[j] = (f32x4){bflo(w.x), bfhi(w.x), bflo(w.y), bfhi(w.y)}; s += (v[j].x * v[j].x + v[j].y * v[j].y) + (v[j].z * v[j].z + v[j].w * v[j].w); }
                const float rs = rsqrtf(wave_sum(s) * (1.0f / DM) + EPS);
#pragma unroll
                for (int j = 0; j < 4; ++j) { const f32x4 g4 = ((const f32x4*)gf)[lane + 64 * j]; xr[64 * j] = v[j] * rs * g4; }
            }
            }
        } else if (sub == 3 || sub == 18) {
            continue;
        } else if (sub == 0 && PON(0)) {
            LOCAL_LANE;
            {
                if (layer == 0) {
                    for (int idx = bx * 512 + tid; idx < 8192 * 48; idx += G * 512) { const int pos = idx / 48, j = idx - pos * 48;
                        const bool ism = j < 16; const int jj = ism ? j : j - 16;
                        const float inv = exp2f(-(float)jj * (ism ? (1.0f / 16.0f) : (1.0f / 32.0f)) * 13.287712379549449f);
                        const float ang = (float)pos * inv; float* dst = ism ? TABM + ((size_t)pos * 16 + jj) * 2 : TABS + ((size_t)pos * 32 + jj) * 2;
                        dst[0] = cosf(ang); dst[1] = sinf(ang); }
                }
                float* scr = (float*)(lds + wave * 8448);
                const size_t L = (size_t)layer;
                for (int it = gw; it < 12784; it += NGW) {
                    int r = it;
                    if (r < 2816) { conv_item(ap->in[3] + L * 1024 * 5632, 1024, 5632, 0, r, ap->in[2] + L * 1024, Wb, scr, lane); continue; } r -= 2816;
                    if (r < 2816) { conv_item(ap->in[18] + L * 1024 * 5632, 1024, 5632, 2, r, ap->in[17] + L * 1024, Wb, scr, lane); continue; } r -= 2816;
                    if (r < 2896) { conv_item(ap->in[6] + L * 1024 * 5792, 1024, 5792, 4, r, ap->in[5] + L * 1024, Wb, scr, lane); continue; } r -= 2896;
                    if (r < 1408) { conv_item(ap->in[4] + L * 2816 * 1024, 2816, 1024, 1, r, nullptr, Wb, scr, lane); continue; } r -= 1408;
                    if (r < 1408) { conv_item(ap->in[19] + L * 2816 * 1024, 2816, 1024, 3, r, nullptr, Wb, scr, lane); continue; } r -= 1408;
                    if (r < 512) { conv_item(ap->in[16] + L * 1024 * 1024, 1024, 1024, 10, r, nullptr, Wb, scr, lane); continue; } r -= 512;
                    if (r < 256) { conv_item(ap->in[11] + L * 512 * 1024, 512, 1024, 7, r, nullptr, Wb, scr, lane); continue; } r -= 256;
                    if (r < 256) { conv_item(ap->in[13] + L * 512 * 1024, 512, 1024, 8, r, nullptr, Wb, scr, lane); continue; } r -= 256;
                    if (r < 256) { conv_item(ap->in[15] + L * 512 * 1024, 512, 1024, 9, r, nullptr, Wb, scr, lane); continue; } r -= 256;
                    if (r < 96) { conv_item(ap->in[8] + L * 256 * 768, 256, 768, 5, r, ap->in[7] + L * 256, Wb, scr, lane); continue; } r -= 96;
                    conv_item(ap->in[10] + L * 128 * 1024, 128, 1024, 6, r, ap->in[9] + L * 128, Wb, scr, lane);
                }
            }
            if (layer == 0) {
                for (int row = gw; row < T; row += NGW) {
                    const float* src = row < TP ? ap->in[0] + (size_t)row * DM : ap->in[1] + (size_t)(row - TP) * DM;
                    const f32x4* xr = (const f32x4*)src + lane; f32x4 v[4]; float sq = 0.f;
#pragma unroll
                    for (int j = 0; j < 4; ++j) { v[j] = xr[64 * j]; sq += (v[j].x * v[j].x + v[j].y * v[j].y) + (v[j].z * v[j].z + v[j].w * v[j].w); }
                    sq = wave_sum(sq);
                    u32x2* o8 = (u32x2*)(HB + (size_t)row * DM) + lane;
#pragma unroll
                    for (int j = 0; j < 4; ++j) { u32x2 w; w.x = pk2(v[j].x, v[j].y); w.y = pk2(v[j].z, v[j].w); o8[64 * j] = w; }
                    if (lane < 16) ssq_x[(size_t)row * 16 + lane] = lane == 0 ? sq : 0.f;
                }
            }
        } else if ((sub == 1 || sub == 19) && PON(1)) {
            pg8::Gemm g{HB, (const bf16_t*)(Wb + (sub == 1 ? O_GU1 : O_GU2)), T, 2 * FF, DM, DM, DM}; pg8::StaticOrder S; S.init(T, 2 * FF, G, bx);
            EpiSwiGLU E{ACT, ssq_x};
            pg8::gemm_phase(ldsl, g, S, E, tid);
        } else if ((sub == 2 || sub == 20 || sub == 17) && PON(2)) {
            const bool wo = (sub == 17);
            const bf16_t* Aop = wo ? MERGED : ACT; const bf16_t* Bop = (const bf16_t*)(Wb + (sub == 2 ? O_DN1 : sub == 20 ? O_DN2 : O_WO));
            int Kd = wo ? DM : FF; asm volatile("" : "+s"(Kd));
            float alpha = wo ? 1.0f : 0.5f; asm volatile("" : "+v"(alpha));
            pg8::Gemm g; g.A = Aop; g.Bt = Bop; g.M = T; g.N = DM; g.K = Kd; g.lda = Kd; g.ldb = Kd;
            pg8::StaticOrder S; S.init(T, DM, G, bx);
            EpiResid E; E.X = X; E.alpha = alpha; E.XB = HB; E.ssq_x = ssq_x;
            pg8::gemm_phase<EpiResid, pg8::StaticOrder, false>(ldsl, g, S, E, tid);
        } else if (sub == 4 && PON(4)) {
            pg8::Gemm g{HB, (const bf16_t*)(Wb + O_WIN), T, 2816, DM, DM, DM}; pg8::StaticOrder S; S.init(T, 2816, G, bx);
            EpiWin E{LAT, CONVB, CONVZ, SWAQK, ssq_q, ssq_kv, TABM, TABS, ssq_x};
            pg8::gemm_phase(ldsl, g, S, E, tid);
            sync_after = false;
        } else if ((sub == 5 || sub == 9) && PON(5)) {
            const bool sv = sub == 5;
            pg8::Gemm g{(const bf16_t*)(Wb + (sv ? O_WSV : O_WUV)), sv ? HB : LAT + 256, sv ? 256 : 512, T, sv ? DM : 128, sv ? DM : 128, sv ? DM : 512};
            pg8::StaticOrder S; if (sv) S.init(256, T, 128, bx >= G - 128 ? bx - (G - 128) : (1 << 24)); else S.init(512, T, G, bx);
            EpiColScaleT E{sv ? SWAVT : VT, sv ? ssq_x : ssq_kv, sv ? 128 : 512, sv};
            pg8::gemm_phase(ldsl, g, S, E, tid);
        } else if (sub == 6 && PON(6)) {
            LOCAL_LANE;
            const float* cw = ap->in[12] + (size_t)layer * 1536; float w0[8], w1[8], w2[8];
#pragma unroll
            for (int e = 0; e < 8; ++e) { w0[e] = cw[8 * lane + e]; w1[e] = cw[512 + 8 * lane + e]; w2[e] = cw[1024 + 8 * lane + e]; }
            for (int row = gw; row < T; row += NGW) {
                const int pos = tok_pos(row), S_ = row < TP ? 4096 : 8192;
                const u32x4 zc = *(const u32x4*)(CONVZ + (size_t)row * 512 + 8 * lane), bb = *(const u32x4*)(CONVB + (size_t)row * 512 + 8 * lane);
                u32x4 zp = (u32x4){0u, 0u, 0u, 0u}, zn = zp;
                if (pos > 0) zp = *(const u32x4*)(CONVZ + (size_t)(row - 1) * 512 + 8 * lane);
                if (pos < S_ - 1) zn = *(const u32x4*)(CONVZ + (size_t)(row + 1) * 512 + 8 * lane);
                f32x4 c0, c1, p0, p1, n0, n1, b0, b1; unpack8(zc, c0, c1); unpack8(zp, p0, p1); unpack8(zn, n0, n1); unpack8(bb, b0, b1);
                f32x4 y0, y1;
#pragma unroll
                for (int e = 0; e < 4; ++e) { y0[e] = b0[e] * (w0[e] * p0[e] + w1[e] * c0[e] + w2[e] * n0[e]); y1[e] = b1[e] * (w0[4 + e] * p1[e] + w1[4 + e] * c1[e] + w2[4 + e] * n1[e]); }
                *(u32x4*)(CB + (size_t)row * 512 + 8 * lane) = pack8(y0, y1);
            }
            sync_after = false;
        } else if (sub == 7 && PON(7)) {
            pg8::Gemm g{LAT, (const bf16_t*)(Wb + O_WUQ), T, 768, 256, 512, 256}; pg8::StaticOrder S; S.init(T, 768, G, bx);
            EpiQ E{Q, ssq_q, TABM};
            pg8::gemm_phase(ldsl, g, S, E, tid);
            sync_after = false;
        } else if (sub == 8 && PON(8)) {
            pg8::Gemm g{LAT + 256, (const bf16_t*)(Wb + O_WUK), T, 512, 128, 512, 128}; pg8::StaticOrder S; S.init(T, 512, G, bx);
            EpiRowScale E{KNOPE, ssq_kv};
            pg8::gemm_phase(ldsl, g, S, E, tid);
            sync_after = false;
        } else if (sub == 10 && PON(10)) {
            LOCAL_LANE;
            const int wv = wave, l32 = lane & 31;
            for (int u = vcu; u < 512; u += G) {
                const int bh = u >> 5, qb = u & 31, b = bh >> 3, h = bh & 7; const size_t base = TP + (size_t)b * 8192; const size_t qrow = base + 256 * qb + 32 * wv + l32;
                attn_unit<false>(lds, ldsl, Q + qrow * 768 + h * 96, KNOPE + base * 512 + h * 64, 512, LAT + base * 512 + 384, VT + (size_t)(h * 64) * T + base, 128, -1e30f, 0.f, 0, OA + (qrow - l32) * 512 + h * 64, tid);
            }
            for (int u = vcu; u < 512; u += G) {
                const int bh = u >> 4, qb = u & 15, b = bh >> 3, h = bh & 7; const size_t base = (size_t)b * 4096; const size_t qrow = base + 256 * qb + 32 * wv + l32;
                attn_unit<false>(lds, ldsl, Q + qrow * 768 + h * 96, KNOPE + base * 512 + h * 64, 512, LAT + base * 512 + 384, VT + (size_t)(h * 64) * T + base, 64, -1e30f, 0.f, 0, OA + (qrow - l32) * 512 + h * 64, tid);
            }
            const float* sink = ap->in[14] + (size_t)layer * 8;
            for (int u = vcu * 4; u < 1024; u += G * 4)
                for (int k = 0; k < 4; ++k) {
                    const int uu = u + k, hp = uu & 1, g2 = (uu >> 1) & 1, nblk = uu >> 2; const int row0 = nblk * 128;
                    const int S_ = row0 < TP ? 4096 : 8192; const int base = row0 < TP ? (row0 & ~4095) : TP + ((row0 - TP) & ~8191);
                    const int n = (row0 - base) >> 7; const int t_lo = n > 0 ? 2 * (n - 1) : 0; int t_hi = 2 * (n + 2); if (t_hi > S_ / 64) t_hi = S_ / 64;
                    const int head = 4 * g2 + 2 * hp + (wv >> 2); const int qpos = 128 * n + 32 * (wv & 3) + l32; const size_t qrow = (size_t)base + qpos; const size_t kbase = (size_t)base + 64 * t_lo;
                    attn_unit<true>(lds, ldsl, SWAQK + qrow * 768 + head * 64, SWAQK + kbase * 768 + 512 + g2 * 64, 768, SWAQK, SWAVT + (size_t)(g2 * 64) * T + kbase, t_hi - t_lo,
                                    sink[head] * LOG2E, (lane >> 5) == 0 ? 1.0f : 0.0f, qpos - 64 * t_lo, OC + (qrow - l32) * 512 + head * 64, tid);
                }
        } else if (sub == 11 && PON(11)) {
            UnitMajor6 S; S.S.init(T, DM, G, bx);
            GSelMerge GS{ws, Wb};
            EpiGateMerge E{(unsigned char*)GB, MERGED, ssq_x};
            pg8::gemm_multi(ldsl, GS, S, E, tid);
        } else if (sub >= 12 && sub <= 16) {
            continue;
        }
        if (DUP_SUB >= 0 && sub == DUP_SUB && ph != 84 && !dup_done) { dup_done = true; --ph; xcd_barrier(xbar); continue; }
        dup_done = false;
        if (sync_after && ph + 1 < a.ph_hi) { if (ph == a.ph_lo) grid.sync(); else xcd_barrier(xbar); }
    }
}

extern "C" void kernel_launch(void* const* d_in, const int* in_sizes, int n_in, void* d_out, int out_size, void* d_ws, size_t ws_size, hipStream_t stream) {
    static int grid = 0;
    if (grid == 0) {
        if (n_in != 21 || out_size != T * DM || ws_size < WS_END) { fprintf(stderr, "kernel_launch: unexpected problem: n_in %d out %d ws %zu (need %zu)\n", n_in, out_size, ws_size, (size_t)WS_END); grid = -1; return; }
        int dev = 0, cus = 0, per_cu = 0;
        hipGetDevice(&dev); hipDeviceGetAttribute(&cus, hipDeviceAttributeMultiprocessorCount, dev);
        if (hipFuncSetAttribute((const void*)mk_fwd, hipFuncAttributeMaxDynamicSharedMemorySize, LDS_BYTES) != hipSuccess) { fprintf(stderr, "kernel_launch: hipFuncSetAttribute failed\n"); grid = -1; return; }
        if (hipOccupancyMaxActiveBlocksPerMultiprocessor(&per_cu, (const void*)mk_fwd, 512, LDS_BYTES) != hipSuccess || per_cu < 1) { fprintf(stderr, "kernel_launch: occupancy query says %d\n", per_cu); per_cu = 1; }
        (void)hipGetLastError();
        grid = cus;
    }
    if (grid < 0) return;
    Args a{};
    for (int i = 0; i < 21; ++i) a.in[i] = (const float*)d_in[i];
    a.out = (float*)d_out; a.ws = (unsigned char*)d_ws;
#if ONE_LAUNCH
    if (hipMemsetAsync((char*)d_ws + WS_BAR, 0, BAR_BYTES, stream) != hipSuccess) { fprintf(stderr, "kernel_launch: memset failed\n"); return; }
    a.ph_lo = 0; a.ph_hi = NPH;
    void* args[] = {&a};
    hipError_t e = hipLaunchCooperativeKernel((const void*)mk_fwd, dim3(grid), dim3(512), args, LDS_BYTES, stream);
    if (e != hipSuccess) fprintf(stderr, "kernel_launch: cooperative launch failed: %s (grid %d)\n", hipGetErrorString(e), grid);
#else
    for (int ph = 0; ph < NPH; ++ph) { a.ph_lo = ph; a.ph_hi = ph + 1; hipLaunchKernelGGL(mk_fwd, dim3(grid), dim3(512), LDS_BYTES, stream, a); }
#endif
}
```

```cpp
#include <hip/hip_runtime.h>
#include <hip/hip_cooperative_groups.h>
#include <cstdio>
#include <cstdint>
namespace cg = cooperative_groups;

#ifndef ONE_LAUNCH
#define ONE_LAUNCH 1
#endif

#ifndef DUP_SUB
#define DUP_SUB -1
#endif
#ifndef ONLY
#define ONLY -1
#endif
#define PON(k) (ONLY < 0 || ONLY == (k))
#define LAS __attribute__((address_space(3)))
typedef unsigned short bf16_t;
typedef short bf16x8 __attribute__((ext_vector_type(8)));
typedef float f32x4 __attribute__((ext_vector_type(4)));
typedef float f32x16 __attribute__((ext_vector_type(16)));
typedef unsigned u32x4 __attribute__((ext_vector_type(4)));
typedef unsigned u32x2 __attribute__((ext_vector_type(2)));
typedef float f32x2_t __attribute__((ext_vector_type(2)));
typedef __bf16 bf16x2_t __attribute__((ext_vector_type(2)));

constexpr int T = 32768, TP = 16384, DM = 1024, FF = 2816;
constexpr float EPS = 1e-6f, LOG2E = 1.4426950408889634f;
constexpr int NPH = 85;

constexpr size_t MiB = 1u << 20;
constexpr size_t WS_SSQQ = 0, WS_SSQKV = 524288;
constexpr size_t WS_TABM = 1 * MiB, WS_TABS = 2 * MiB;
constexpr size_t WS_W = 4 * MiB;
constexpr size_t WS_BAR = 55 * MiB, BAR_BYTES = 16384;
constexpr size_t WS_HB = 56 * MiB;
constexpr size_t WS_BIG = 120 * MiB;
constexpr size_t WS_ACT = WS_BIG;
constexpr size_t WS_LAT = WS_BIG;
constexpr size_t WS_CONVB = WS_BIG + 32 * MiB;
constexpr size_t WS_CONVZ = WS_BIG + 64 * MiB;
constexpr size_t WS_SWAQK = WS_BIG + 96 * MiB;
constexpr size_t WS_SWAVT = WS_BIG + 144 * MiB;
constexpr size_t WS_CB = WS_BIG + 152 * MiB;
constexpr size_t WS_Q = WS_BIG + 184 * MiB;
constexpr size_t WS_KNOPE = WS_BIG + 232 * MiB;
constexpr size_t WS_VT = WS_BIG + 264 * MiB;
constexpr size_t WS_G = WS_BIG + 296 * MiB;
constexpr size_t WS_MERGED = WS_Q;
constexpr size_t WS_SSQX = WS_BIG + 360 * MiB;
constexpr size_t WS_END = WS_BIG + 362 * MiB;
constexpr size_t O_GU1 = 0, O_DN1 = 11534336, O_GU2 = 17301504, O_DN2 = 28835840, O_WIN = 34603008, O_WG = 40370176, O_WSV = 46661632,
                 O_WUQ = 47185920, O_WUK = 47579136, O_WUV = 47710208, O_WAO = 47841280, O_WBO = 48889856, O_WCO = 49938432, O_WO = 50987008;

constexpr int LDS_BYTES = 147456;

__device__ __forceinline__ unsigned pk2(float lo, float hi) { f32x2_t v = {lo, hi}; bf16x2_t b = __builtin_convertvector(v, bf16x2_t); return __builtin_bit_cast(unsigned, b); }
__device__ __forceinline__ float bflo(unsigned u) { return __uint_as_float(u << 16); }
__device__ __forceinline__ float bfhi(unsigned u) { return __uint_as_float(u & 0xffff0000u); }
__device__ __forceinline__ u32x4 pack8(f32x4 a, f32x4 b) { u32x4 w; w.x = pk2(a[0], a[1]); w.y = pk2(a[2], a[3]); w.z = pk2(b[0], b[1]); w.w = pk2(b[2], b[3]); return w; }
__device__ __forceinline__ void unpack8(u32x4 w, f32x4& a, f32x4& b) { a = (f32x4){bflo(w.x), bfhi(w.x), bflo(w.y), bfhi(w.y)}; b = (f32x4){bflo(w.z), bfhi(w.z), bflo(w.w), bfhi(w.w)}; }
__device__ __forceinline__ float wave_sum(float v) {
#pragma unroll
    for (int o = 1; o < 64; o <<= 1) v += __shfl_xor(v, o);
    return v;
}
__device__ __forceinline__ float fast_sigmoid(float x) { return __builtin_amdgcn_rcpf(1.0f + __builtin_amdgcn_exp2f(-x * LOG2E)); }
__device__ __forceinline__ int tok_pos(int row) { return row < TP ? (row & 4095) : (row & 8191); }
__device__ __forceinline__ void rope8(f32x4& v0, f32x4& v1, const float* tab) {
    const f32x4 t0 = *(const f32x4*)tab, t1 = *(const f32x4*)(tab + 4);
    float a, b;
    a = v0[0] * t0[0] - v0[1] * t0[1]; b = v0[1] * t0[0] + v0[0] * t0[1]; v0[0] = a; v0[1] = b;
    a = v0[2] * t0[2] - v0[3] * t0[3]; b = v0[3] * t0[2] + v0[2] * t0[3]; v0[2] = a; v0[3] = b;
    a = v1[0] * t1[0] - v1[1] * t1[1]; b = v1[1] * t1[0] + v1[0] * t1[1]; v1[0] = a; v1[1] = b;
    a = v1[2] * t1[2] - v1[3] * t1[3]; b = v1[3] * t1[2] + v1[2] * t1[3]; v1[2] = a; v1[3] = b;
}

__device__ __forceinline__ float row_rs16(const float* ssq_x, int row) {
    const f32x4* p = (const f32x4*)(ssq_x + (size_t)row * 16); const f32x4 a = p[0], b = p[1], c = p[2], d = p[3];
    return rsqrtf((((a[0] + a[1]) + (a[2] + a[3])) + ((b[0] + b[1]) + (b[2] + b[3])) + ((c[0] + c[1]) + (c[2] + c[3])) + ((d[0] + d[1]) + (d[2] + d[3]))) * (1.0f / DM) + EPS);
}

struct RsCtx { const LAS float* t; int p0, p1; const float* ssq_x;
    __device__ __forceinline__ float get(int key, int idx, int row) const { return key == p0 ? t[idx] : key == p1 ? t[256 + idx] : row_rs16(ssq_x, row); } };

namespace pg8 {
constexpr int BM = 256, BK = 64, HALF = 128, HTB = HALF * BK * 2, STAGE_BYTES = 8 * HTB, NXCD = 8, WGM = 8;
__host__ __device__ __forceinline__ int lds_byte(int r, int c) { const int st = (r >> 4) * 2 + (c >> 5), rr = r & 15, cc = c & 31, ob = rr * 64 + cc * 2; return st * 1024 + (ob ^ (((ob >> 9) & 1) << 5)); }
__host__ __device__ __forceinline__ void stage_rc(int b, int& R, int& C) { const int st = b / 1024, sb = b % 1024, swz = sb ^ (((sb >> 9) & 1) << 5); R = (st >> 1) * 16 + swz / 64; C = (st & 1) * 32 + (swz % 64) / 2; }
__host__ __device__ __forceinline__ int perm32(int rho) { const int n = rho >> 4, i = rho & 15; return 8 * (i >> 2) + 4 * n + (i & 3); }

struct Unit { int pm, pn, kind; };
struct Gemm { const bf16_t* A; const bf16_t* Bt; int M, N, K, lda, ldb; };

struct StaticOrder {
    int nM, nN, nwg, G, c;
    __host__ __device__ void init(int M, int N, int G_, int c_) { nM = M / BM; nN = N / BM; nwg = nM * nN; G = G_; c = c_; }
    __host__ __device__ bool next(int i, Unit& u) const {
        const long L = (long)i * G + c; if (L >= nwg) return false;
        int wgid = (int)L; { const int q = nwg / NXCD, r = nwg % NXCD, xcd = wgid % NXCD, off = wgid / NXCD; wgid = (xcd < r ? xcd * (q + 1) : r * (q + 1) + (xcd - r) * q) + off; }
        const int nig = WGM * nN, gid = wgid / nig, fm = gid * WGM, gsz = (nM - fm) < WGM ? (nM - fm) : WGM;
        u.pm = fm + ((wgid % nig) % gsz); u.pn = (wgid % nig) / gsz; u.kind = 0; return true;
    }
};

template <class Epi, class Sched>
__device__ __forceinline__ void gemm_phase(LAS unsigned char* lds, const Gemm g, const Sched S, const Epi E, const int tid) {
    const int wid = __builtin_amdgcn_readfirstlane(tid >> 6), lane = tid & 63, wr = wid >> 2, wc = wid & 3, fr = lane & 15, fq = lane >> 4;
    int K = g.K; asm volatile("" : "+s"(K)); const int nt = K / BK;
    unsigned voffA[2], voffB[2];
#pragma unroll
    for (int i = 0; i < 2; ++i) { int R, C; stage_rc(tid * 16 + i * 8192, R, C); const int Rb = (R & ~31) + perm32(R & 31);
        voffA[i] = (unsigned)(R * g.lda + C) * 2u; voffB[i] = (unsigned)(Rb * g.ldb + C) * 2u; }
    const size_t kstep = (size_t)(BK * 2);
    const size_t hstepA = (size_t)HALF * g.lda * 2, hstepB = (size_t)HALF * g.ldb * 2;
    const size_t tstepA = 2 * hstepA, tstepB = 2 * hstepB;
    const unsigned ldsw = (unsigned)wid * 1024u;
    const int aoff = lds_byte(wr * 64 + fr, fq * 8), boff = lds_byte(wc * 32 + fr, fq * 8);
#define PG8_SA(b, h) (((b) * 2 + (h)) * HTB)
#define PG8_SB(b, h) ((4 + (b) * 2 + (h)) * HTB)
#define PG8_STAGE(bufoff, gbase, voff) do { _Pragma("unroll") for (int _i = 0; _i < 2; ++_i) \
        __builtin_amdgcn_global_load_lds((const unsigned*)((const char*)(gbase) + (voff)[_i]), (LAS unsigned*)(lds + (bufoff) + ldsw + _i * 8192), 16, 0, 0); } while (0)
#define PG8_LDA(dst, b, h) do { _Pragma("unroll") for (int m = 0; m < 4; ++m) _Pragma("unroll") for (int k = 0; k < 2; ++k) dst[m][k] = *(const LAS bf16x8*)(lds + PG8_SA(b, h) + aoff + m * 2048 + k * 1024); } while (0)
#define PG8_LDB(dst, b, h) do { _Pragma("unroll") for (int n = 0; n < 2; ++n) _Pragma("unroll") for (int k = 0; k < 2; ++k) dst[n][k] = *(const LAS bf16x8*)(lds + PG8_SB(b, h) + boff + n * 2048 + k * 1024); } while (0)
#define PG8_MMA(ai, bj, At, Bt) do { __builtin_amdgcn_s_setprio(1); _Pragma("unroll") for (int m = 0; m < 4; ++m) _Pragma("unroll") for (int n = 0; n < 2; ++n) _Pragma("unroll") for (int k = 0; k < 2; ++k) \
        acc[ai][bj][m][n] = __builtin_amdgcn_mfma_f32_16x16x32_bf16(Bt[n][k], At[m][k], acc[ai][bj][m][n], 0, 0, 0); __builtin_amdgcn_s_setprio(0); } while (0)
#define PG8_WAIT_V(n) asm volatile("s_waitcnt vmcnt(" #n ")" ::: "memory")
#define PG8_WAIT_L(n) asm volatile("s_waitcnt lgkmcnt(" #n ")" ::: "memory")
#define PG8_BAR __builtin_amdgcn_s_barrier()
#define PG8_SCHED __builtin_amdgcn_sched_barrier(0)
    Unit cur, nxt; int ui = 0;
    if (!S.next(0, cur)) return;
    RsCtx rc; rc.t = (const LAS float*)(lds + 132096); rc.p0 = -1; rc.p1 = -1; rc.ssq_x = nullptr;
    if constexpr (Epi::RS16 != 0) {
        rc.ssq_x = E.ssq_x; Unit uu;
        for (int i = 0; S.next(i, uu); ++i) { const int key = Epi::RS16 == 2 ? uu.pn : uu.pm; if (key != rc.p0 && key != rc.p1) { if (rc.p0 < 0) rc.p0 = key; else if (rc.p1 < 0) rc.p1 = key; } }
        const int key = tid < 256 ? rc.p0 : rc.p1;
        if (key >= 0) ((LAS float*)(lds + 132096))[tid] = row_rs16(E.ssq_x, key * 256 + (tid & 255));
        asm volatile("s_waitcnt vmcnt(0) lgkmcnt(0)" ::: "memory"); __builtin_amdgcn_s_barrier(); asm volatile("" ::: "memory");
    }
    f32x4 acc[2][2][4][2];
#pragma unroll
    for (int a = 0; a < 2; ++a)
#pragma unroll
        for (int b = 0; b < 2; ++b)
#pragma unroll
            for (int m = 0; m < 4; ++m)
#pragma unroll
                for (int n = 0; n < 2; ++n) acc[a][b][m][n] = (f32x4){0.f, 0.f, 0.f, 0.f};
    bf16x8 At[4][2], B0[2][2], B1[2][2];
    const char* cA = (const char*)g.A + (size_t)cur.pm * tstepA; const char* cB = (const char*)g.Bt + (size_t)cur.pn * tstepB;
    PG8_STAGE(PG8_SB(0, 0), cB, voffB); PG8_STAGE(PG8_SB(0, 1), cB + hstepB, voffB); PG8_STAGE(PG8_SA(0, 0), cA, voffA); PG8_STAGE(PG8_SA(0, 1), cA + hstepA, voffA);
    if (wr == 1) PG8_BAR;
    PG8_WAIT_V(2); PG8_BAR;
    PG8_STAGE(PG8_SB(1, 0), cB + kstep, voffB); PG8_STAGE(PG8_SA(1, 0), cA + kstep, voffA); PG8_STAGE(PG8_SB(1, 1), cB + hstepB + kstep, voffB);
    PG8_WAIT_V(6); PG8_BAR;
    for (;;) {
        const bool has_next = S.next(ui + 1, nxt);
        const char* nA = has_next ? (const char*)g.A + (size_t)nxt.pm * tstepA : cA; const char* nB = has_next ? (const char*)g.Bt + (size_t)nxt.pn * tstepB : cB;
        for (int t = 0; t < nt; t += 2) {
            const bool last = (t == nt - 2);
            const char* a1 = cA + (size_t)(t + 1) * kstep;
            const char* a2 = last ? nA : cA + (size_t)(t + 2) * kstep; const char* b2 = last ? nB : cB + (size_t)(t + 2) * kstep;
            const char* a3 = a2 + kstep; const char* b3 = b2 + kstep;
            PG8_LDB(B0, 0, 0); PG8_LDB(B1, 0, 1); PG8_SCHED; PG8_LDA(At, 0, 0); PG8_STAGE(PG8_SA(1, 1), a1 + hstepA, voffA);
            PG8_WAIT_V(8); PG8_WAIT_L(0); PG8_BAR; PG8_MMA(0, 0, At, B0); PG8_MMA(0, 1, At, B1); PG8_BAR; PG8_SCHED;
            PG8_LDA(At, 0, 1); PG8_STAGE(PG8_SB(0, 0), b2, voffB); PG8_STAGE(PG8_SB(0, 1), b2 + hstepB, voffB); PG8_STAGE(PG8_SA(0, 0), a2, voffA);
            PG8_WAIT_V(8); PG8_WAIT_L(0); PG8_BAR; PG8_MMA(1, 0, At, B0); PG8_MMA(1, 1, At, B1); PG8_BAR; PG8_SCHED;
            PG8_LDB(B0, 1, 0); PG8_LDB(B1, 1, 1); PG8_SCHED; PG8_LDA(At, 1, 0); PG8_STAGE(PG8_SA(0, 1), a2 + hstepA, voffA);
            PG8_WAIT_V(8); PG8_WAIT_L(0); PG8_BAR; PG8_MMA(0, 0, At, B0); PG8_MMA(0, 1, At, B1); PG8_BAR; PG8_SCHED;
            PG8_LDA(At, 1, 1); PG8_STAGE(PG8_SB(1, 0), b3, voffB); PG8_STAGE(PG8_SB(1, 1), b3 + hstepB, voffB); PG8_STAGE(PG8_SA(1, 0), a3, voffA);
            PG8_WAIT_V(8); PG8_WAIT_L(0); PG8_BAR; PG8_MMA(1, 0, At, B0); PG8_MMA(1, 1, At, B1); PG8_BAR; PG8_SCHED;
        }
        if (wr == 0) PG8_BAR;
        E(acc, cur, wr, wc, fr, fq, rc);
        if (!has_next) break;
#pragma unroll
        for (int a = 0; a < 2; ++a)
#pragma unroll
            for (int b = 0; b < 2; ++b)
#pragma unroll
                for (int m = 0; m < 4; ++m)
#pragma unroll
                    for (int n = 0; n < 2; ++n) acc[a][b][m][n] = (f32x4){0.f, 0.f, 0.f, 0.f};
        cur = nxt; cA = nA; cB = nB; ++ui;
        if (wr == 1) PG8_BAR;
    }
    PG8_WAIT_V(0);
    PG8_BAR;
#undef PG8_SA
#undef PG8_SB
#undef PG8_STAGE
#undef PG8_LDA
#undef PG8_LDB
#undef PG8_MMA
#undef PG8_WAIT_V
#undef PG8_WAIT_L
#undef PG8_BAR
#undef PG8_SCHED
}

template <class Epi, class Sched, class GSel>
__device__ __forceinline__ void gemm_multi(LAS unsigned char* lds, const GSel GS, const Sched S, const Epi E, const int tid) {
    const int wid = __builtin_amdgcn_readfirstlane(tid >> 6), lane = tid & 63, wr = wid >> 2, wc = wid & 3, fr = lane & 15, fq = lane >> 4;
    const size_t kstep = (size_t)(BK * 2);
    const unsigned ldsw = (unsigned)wid * 1024u;
    const int aoff = lds_byte(wr * 64 + fr, fq * 8), boff = lds_byte(wc * 32 + fr, fq * 8);
#define PGM_VOFF(vA, vB, g) do { int R_, C_; stage_rc(tid * 16, R_, C_); const int Rb_ = (R_ & ~31) + perm32(R_ & 31); \
        vA = (unsigned)(R_ * (g).lda + C_) * 2u; vB = (unsigned)(Rb_ * (g).ldb + C_) * 2u; } while (0)
#define PG8_SA(b, h) (((b) * 2 + (h)) * HTB)
#define PG8_SB(b, h) ((4 + (b) * 2 + (h)) * HTB)
#define PG8_STAGE(bufoff, gbase, voff, q64) do { \
        __builtin_amdgcn_global_load_lds((const unsigned*)((const char*)(gbase) + (voff)), (LAS unsigned*)(lds + (bufoff) + ldsw), 16, 0, 0); \
        __builtin_amdgcn_global_load_lds((const unsigned*)((const char*)(gbase) + (q64) + (voff)), (LAS unsigned*)(lds + (bufoff) + ldsw + 8192), 16, 0, 0); } while (0)
#define PG8_LDA(dst, b, h) do { _Pragma("unroll") for (int m = 0; m < 4; ++m) _Pragma("unroll") for (int k = 0; k < 2; ++k) dst[m][k] = *(const LAS bf16x8*)(lds + PG8_SA(b, h) + aoff + m * 2048 + k * 1024); } while (0)
#define PG8_LDB(dst, b, h) do { _Pragma("unroll") for (int n = 0; n < 2; ++n) _Pragma("unroll") for (int k = 0; k < 2; ++k) dst[n][k] = *(const LAS bf16x8*)(lds + PG8_SB(b, h) + boff + n * 2048 + k * 1024); } while (0)
#define PG8_MMA(ai, bj, At, Bt) do { __builtin_amdgcn_s_setprio(1); _Pragma("unroll") for (int m = 0; m < 4; ++m) _Pragma("unroll") for (int n = 0; n < 2; ++n) _Pragma("unroll") for (int k = 0; k < 2; ++k) \
        acc[ai][bj][m][n] = __builtin_amdgcn_mfma_f32_16x16x32_bf16(Bt[n][k], At[m][k], acc[ai][bj][m][n], 0, 0, 0); __builtin_amdgcn_s_setprio(0); } while (0)
#define PG8_WAIT_V(n) asm volatile("s_waitcnt vmcnt(" #n ")" ::: "memory")
#define PG8_WAIT_L(n) asm volatile("s_waitcnt lgkmcnt(" #n ")" ::: "memory")
#define PG8_BAR __builtin_amdgcn_s_barrier()
#define PG8_SCHED __builtin_amdgcn_sched_barrier(0)
    Unit cur, nxt; int ui = 0;
    if (!S.next(0, cur)) return;
    RsCtx rc; rc.t = (const LAS float*)(lds + 132096); rc.p0 = -1; rc.p1 = -1; rc.ssq_x = nullptr;
    if constexpr (Epi::RS16 != 0) {
        rc.ssq_x = E.ssq_x; Unit uu;
        for (int i = 0; S.next(i, uu); ++i) { if (!Epi::rs_kind(uu.kind)) continue; const int key = uu.pm; if (key != rc.p0 && key != rc.p1) { if (rc.p0 < 0) rc.p0 = key; else if (rc.p1 < 0) rc.p1 = key; } }
        const int key = tid < 256 ? rc.p0 : rc.p1;
        if (key >= 0) ((LAS float*)(lds + 132096))[tid] = row_rs16(E.ssq_x, key * 256 + (tid & 255));
        asm volatile("s_waitcnt vmcnt(0) lgkmcnt(0)" ::: "memory"); __builtin_amdgcn_s_barrier(); asm volatile("" ::: "memory");
    }
    f32x4 acc[2][2][4][2];
#pragma unroll
    for (int a = 0; a < 2; ++a)
#pragma unroll
        for (int b = 0; b < 2; ++b)
#pragma unroll
            for (int m = 0; m < 4; ++m)
#pragma unroll
                for (int n = 0; n < 2; ++n) acc[a][b][m][n] = (f32x4){0.f, 0.f, 0.f, 0.f};
    bf16x8 At[4][2], B0[2][2], B1[2][2];
    Gemm gc = GS.get(cur.kind);
    int ntc = gc.K / BK; asm volatile("" : "+s"(ntc));
    unsigned vAc, vBc; PGM_VOFF(vAc, vBc, gc);
    size_t hAc = (size_t)HALF * gc.lda * 2, hBc = (size_t)HALF * gc.ldb * 2;
    const char* cA = (const char*)gc.A + (size_t)cur.pm * 2 * hAc; const char* cB = (const char*)gc.Bt + (size_t)cur.pn * 2 * hBc;
    PG8_STAGE(PG8_SB(0, 0), cB, vBc, hBc / 2); PG8_STAGE(PG8_SB(0, 1), cB + hBc, vBc, hBc / 2); PG8_STAGE(PG8_SA(0, 0), cA, vAc, hAc / 2); PG8_STAGE(PG8_SA(0, 1), cA + hAc, vAc, hAc / 2);
    if (wr == 1) PG8_BAR;
    PG8_WAIT_V(2); PG8_BAR;
    PG8_STAGE(PG8_SB(1, 0), cB + kstep, vBc, hBc / 2); PG8_STAGE(PG8_SA(1, 0), cA + kstep, vAc, hAc / 2); PG8_STAGE(PG8_SB(1, 1), cB + hBc + kstep, vBc, hBc / 2);
    PG8_WAIT_V(6); PG8_BAR;
    for (;;) {
        const bool has_next = S.next(ui + 1, nxt);
        if (!has_next) nxt = cur;
        const Gemm gn = GS.get(nxt.kind);
        unsigned vAn, vBn; PGM_VOFF(vAn, vBn, gn);
        const size_t hAn = (size_t)HALF * gn.lda * 2, hBn = (size_t)HALF * gn.ldb * 2;
        const char* nA = (const char*)gn.A + (size_t)nxt.pm * 2 * hAn; const char* nB = (const char*)gn.Bt + (size_t)nxt.pn * 2 * hBn;
        for (int t = 0; t < ntc; t += 2) {
            const bool last = (t == ntc - 2);
            const char* a1 = cA + (size_t)(t + 1) * kstep;
            const char* a2 = last ? nA : cA + (size_t)(t + 2) * kstep; const char* b2 = last ? nB : cB + (size_t)(t + 2) * kstep;
            const char* a3 = a2 + kstep; const char* b3 = b2 + kstep;
            const unsigned vA2 = last ? vAn : vAc, vB2 = last ? vBn : vBc;
            const size_t hA2 = last ? hAn : hAc, hB2 = last ? hBn : hBc;
            PG8_LDB(B0, 0, 0); PG8_LDB(B1, 0, 1); PG8_SCHED; PG8_LDA(At, 0, 0); PG8_STAGE(PG8_SA(1, 1), a1 + hAc, vAc, hAc / 2);
            PG8_WAIT_V(8); PG8_WAIT_L(0); PG8_BAR; PG8_MMA(0, 0, At, B0); PG8_MMA(0, 1, At, B1); PG8_BAR; PG8_SCHED;
            PG8_LDA(At, 0, 1); PG8_STAGE(PG8_SB(0, 0), b2, vB2, hB2 / 2); PG8_STAGE(PG8_SB(0, 1), b2 + hB2, vB2, hB2 / 2); PG8_STAGE(PG8_SA(0, 0), a2, vA2, hA2 / 2);
            PG8_WAIT_V(8); PG8_WAIT_L(0); PG8_BAR; PG8_MMA(1, 0, At, B0); PG8_MMA(1, 1, At, B1); PG8_BAR; PG8_SCHED;
            PG8_LDB(B0, 1, 0); PG8_LDB(B1, 1, 1); PG8_SCHED; PG8_LDA(At, 1, 0); PG8_STAGE(PG8_SA(0, 1), a2 + hA2, vA2, hA2 / 2);
            PG8_WAIT_V(8); PG8_WAIT_L(0); PG8_BAR; PG8_MMA(0, 0, At, B0); PG8_MMA(0, 1, At, B1); PG8_BAR; PG8_SCHED;
            PG8_LDA(At, 1, 1); PG8_STAGE(PG8_SB(1, 0), b3, vB2, hB2 / 2); PG8_STAGE(PG8_SB(1, 1), b3 + hB2, vB2, hB2 / 2); PG8_STAGE(PG8_SA(1, 0), a3, vA2, hA2 / 2);
            PG8_WAIT_V(8); PG8_WAIT_L(0); PG8_BAR; PG8_MMA(1, 0, At, B0); PG8_MMA(1, 1, At, B1); PG8_BAR; PG8_SCHED;
        }
        if (wr == 0) PG8_BAR;
        E(acc, cur, wr, wc, fr, fq, rc);
        if (!has_next) break;
#pragma unroll
        for (int a = 0; a < 2; ++a)
#pragma unroll
            for (int b = 0; b < 2; ++b)
#pragma unroll
                for (int m = 0; m < 4; ++m)
#pragma unroll
                    for (int n = 0; n < 2; ++n) acc[a][b][m][n] = (f32x4){0.f, 0.f, 0.f, 0.f};
        cur = nxt; cA = nA; cB = nB; vAc = vAn; vBc = vBn; hAc = hAn; hBc = hBn; ntc = gn.K / BK; asm volatile("" : "+s"(ntc)); ++ui;
        if (wr == 1) PG8_BAR;
    }
    PG8_WAIT_V(0);
    PG8_BAR;
#undef PGM_VOFF
#undef PG8_SA
#undef PG8_SB
#undef PG8_STAGE
#undef PG8_LDA
#undef PG8_LDB
#undef PG8_MMA
#undef PG8_WAIT_V
#undef PG8_WAIT_L
#undef PG8_BAR
#undef PG8_SCHED
}
}
using pg8::Unit;
typedef f32x4 Acc[2][2][4][2];


#define EPI_ROW(u, ai, wr, m, fr) ((u).pm * 256 + (ai) * 128 + (wr) * 64 + (m) * 16 + (fr))
struct EpiSwiGLU {
    static constexpr int RS16 = 1;
    bf16_t* O; const float* ssq_x;
    __device__ __forceinline__ void operator()(const Acc& acc, const Unit& u, int wr, int wc, int fr, int fq, const RsCtx& rc) const {
        const int col = u.pn * 128 + wc * 32 + 8 * fq;
#pragma unroll
        for (int ai = 0; ai < 2; ++ai)
#pragma unroll
            for (int m = 0; m < 4; ++m) { const int row = EPI_ROW(u, ai, wr, m, fr); const float rs = rc.get(u.pm, ai * 128 + wr * 64 + m * 16 + fr, row);
                f32x4 a0 = acc[ai][0][m][0] * rs, a1 = acc[ai][0][m][1] * rs; const f32x4 b0 = acc[ai][1][m][0] * rs, b1 = acc[ai][1][m][1] * rs;
#pragma unroll
                for (int e = 0; e < 4; ++e) { a0[e] = a0[e] * fast_sigmoid(a0[e]) * b0[e]; a1[e] = a1[e] * fast_sigmoid(a1[e]) * b1[e]; }
                *(u32x4*)(O + (size_t)row * FF + col) = pack8(a0, a1);
                if (m == 3) asm volatile("" ::: "memory"); }
    }
};
struct EpiResid {
    static constexpr int RS16 = 0;
    float* X; bf16_t* XB; float* ssq_x; float alpha;
    __device__ __forceinline__ void operator()(const Acc& acc, const Unit& u, int wr, int wc, int fr, int fq, const RsCtx& rc) const {
#pragma unroll
        for (int ai = 0; ai < 2; ++ai)
#pragma unroll
            for (int m = 0; m < 4; ++m) { const int row = EPI_ROW(u, ai, wr, m, fr); float s = 0.f;
#pragma unroll
                for (int bj = 0; bj < 2; ++bj) { const size_t off = (size_t)row * DM + u.pn * 256 + bj * 128 + wc * 32 + 8 * fq;
                    f32x4 x0, x1; unpack8(*(const u32x4*)(XB + off), x0, x1);
                    x0 = x0 + acc[ai][bj][m][0] * alpha; x1 = x1 + acc[ai][bj][m][1] * alpha;
                    *(u32x4*)(XB + off) = pack8(x0, x1);
#pragma unroll
                    for (int e = 0; e < 4; ++e) s += x0[e] * x0[e] + x1[e] * x1[e]; }
                s += __shfl_xor(s, 16); s += __shfl_xor(s, 32);
                if (fq == 0) ssq_x[(size_t)row * 16 + u.pn * 4 + wc] = s;
                if (m == 3) asm volatile("" ::: "memory"); }
    }
};
struct EpiWin {
    static constexpr int RS16 = 1;
    bf16_t *LAT, *CONVB, *CONVZ, *SWAQK; float *ssq_q, *ssq_kv; const float *TABM, *TABS; const float* ssq_x;
    __device__ __forceinline__ void operator()(const Acc& acc, const Unit& u, int wr, int wc, int fr, int fq, const RsCtx& rc) const {
        const int pn = u.pn, cw = wc * 32 + 8 * fq;
#pragma unroll
        for (int ai = 0; ai < 2; ++ai)
#pragma unroll
            for (int m = 0; m < 4; ++m) { const int row = EPI_ROW(u, ai, wr, m, fr);
                const float rs = rc.get(u.pm, ai * 128 + wr * 64 + m * 16 + fr, row);
                f32x4 a0 = acc[ai][0][m][0] * rs, a1 = acc[ai][0][m][1] * rs, b0 = acc[ai][1][m][0] * rs, b1 = acc[ai][1][m][1] * rs;
                if (pn == 0) {
                    float s = 0.f;
#pragma unroll
                    for (int e = 0; e < 4; ++e) s += a0[e] * a0[e] + a1[e] * a1[e] + b0[e] * b0[e] + b1[e] * b1[e];
                    s += __shfl_xor(s, 16); s += __shfl_xor(s, 32);
                    if (fq == 0) ssq_q[row * 4 + wc] = s;
                    *(u32x4*)(LAT + (size_t)row * 512 + cw) = pack8(a0, a1); *(u32x4*)(LAT + (size_t)row * 512 + 128 + cw) = pack8(b0, b1);
                } else if (pn == 1) {
                    float s = 0.f;
#pragma unroll
                    for (int e = 0; e < 4; ++e) s += a0[e] * a0[e] + a1[e] * a1[e];
                    s += __shfl_xor(s, 16); s += __shfl_xor(s, 32);
                    if (fq == 0) ssq_kv[row * 4 + wc] = s;
                    *(u32x4*)(LAT + (size_t)row * 512 + 256 + cw) = pack8(a0, a1);
                    if (wc == 0) { rope8(b0, b1, TABM + ((size_t)tok_pos(row) * 16 + 4 * fq) * 2); *(u32x4*)(LAT + (size_t)row * 512 + 384 + cw) = pack8(b0, b1); }
                } else if (pn < 4) {
                    bf16_t* p = CONVB + (size_t)row * 512 + (pn - 2) * 256 + cw;
                    *(u32x4*)p = pack8(a0, a1); *(u32x4*)(p + 128) = pack8(b0, b1);
                } else if (pn < 8) {
                    *(u32x4*)(CONVZ + (size_t)row * 512 + (pn - 4) * 128 + cw) = pack8(a0 * b0, a1 * b1);
                } else if (pn < 10) {
                    const int c = (pn - 8) * 256 + cw; const float* tb = TABS + (size_t)tok_pos(row) * 64;
                    rope8(a0, a1, tb + (c & 63)); rope8(b0, b1, tb + ((c + 128) & 63));
                    const float sc = 0.125f * LOG2E;
                    *(u32x4*)(SWAQK + (size_t)row * 768 + c) = pack8(a0 * sc, a1 * sc); *(u32x4*)(SWAQK + (size_t)row * 768 + c + 128) = pack8(b0 * sc, b1 * sc);
                } else {
                    rope8(a0, a1, TABS + (size_t)tok_pos(row) * 64 + (cw & 63));
                    *(u32x4*)(SWAQK + (size_t)row * 768 + 512 + cw) = pack8(a0, a1);
                }
                if (m == 3) asm volatile("" ::: "memory");
            }
    }
};
struct EpiQ {
    static constexpr int RS16 = 0;
    bf16_t* Q; const float* ssq_q; const float* TABM;
    __device__ __forceinline__ void operator()(const Acc& acc, const Unit& u, int wr, int wc, int fr, int fq, const RsCtx& rc) const {
        const float C2 = 0.10206207261596577f * LOG2E;
#pragma unroll
        for (int ai = 0; ai < 2; ++ai)
#pragma unroll
            for (int m = 0; m < 4; ++m) { const int row = EPI_ROW(u, ai, wr, m, fr);
                const f32x4 sp = *(const f32x4*)(ssq_q + row * 4); const float rs = rsqrtf(((sp[0] + sp[1]) + (sp[2] + sp[3])) * (1.0f / 256.0f) + EPS) * C2; const float* tb = TABM + (size_t)tok_pos(row) * 32;
#pragma unroll
                for (int bj = 0; bj < 2; ++bj) { const int c = u.pn * 256 + bj * 128 + wc * 32 + 8 * fq; const int d = c % 96;
                    f32x4 v0 = acc[ai][bj][m][0] * rs, v1 = acc[ai][bj][m][1] * rs;
                    if (d >= 64) rope8(v0, v1, tb + (d - 64));
                    *(u32x4*)(Q + (size_t)row * 768 + c) = pack8(v0, v1); }
                if (m == 3) asm volatile("" ::: "memory"); }
    }
};
struct EpiRowScale {
    static constexpr int RS16 = 0;
    bf16_t* O; const float* ssq;
    __device__ __forceinline__ void operator()(const Acc& acc, const Unit& u, int wr, int wc, int fr, int fq, const RsCtx& rc) const {
#pragma unroll
        for (int ai = 0; ai < 2; ++ai)
#pragma unroll
            for (int m = 0; m < 4; ++m) { const int row = EPI_ROW(u, ai, wr, m, fr); const f32x4 sp = *(const f32x4*)(ssq + row * 4); const float rs = rsqrtf(((sp[0] + sp[1]) + (sp[2] + sp[3])) * (1.0f / 128.0f) + EPS);
#pragma unroll
                for (int bj = 0; bj < 2; ++bj) *(u32x4*)(O + (size_t)row * 512 + u.pn * 256 + bj * 128 + wc * 32 + 8 * fq) = pack8(acc[ai][bj][m][0] * rs, acc[ai][bj][m][1] * rs);
                if (m == 3) asm volatile("" ::: "memory"); }
    }
};
struct EpiColScaleT {
    static constexpr int RS16 = 0;
    bf16_t* O; const float* ssq; int nrows; bool x16;
    __device__ __forceinline__ void operator()(const Acc& acc, const Unit& u, int wr, int wc, int fr, int fq, const RsCtx& rc) const {
#pragma unroll
        for (int bj = 0; bj < 2; ++bj) { const int c = u.pn * 256 + bj * 128 + wc * 32 + 8 * fq;
            f32x4 r0 = (f32x4){1.f, 1.f, 1.f, 1.f}, r1 = r0;
            if (x16) {
#pragma unroll
                for (int e = 0; e < 4; ++e) { r0[e] = row_rs16(ssq, c + e); r1[e] = row_rs16(ssq, c + 4 + e); }
            } else {
#pragma unroll
                for (int e = 0; e < 4; ++e) { const f32x4 sa = *(const f32x4*)(ssq + (c + e) * 4), sb = *(const f32x4*)(ssq + (c + 4 + e) * 4);
                    r0[e] = rsqrtf(((sa[0] + sa[1]) + (sa[2] + sa[3])) * (1.0f / 128.0f) + EPS); r1[e] = rsqrtf(((sb[0] + sb[1]) + (sb[2] + sb[3])) * (1.0f / 128.0f) + EPS); } }
#pragma unroll
            for (int ai = 0; ai < 2; ++ai)
#pragma unroll
                for (int m = 0; m < 4; ++m) { const int row = EPI_ROW(u, ai, wr, m, fr);
                    if (row < nrows) *(u32x4*)(O + (size_t)row * T + c) = pack8(acc[ai][bj][m][0] * r0, acc[ai][bj][m][1] * r1); } }
    }
};
struct EpiGate {
    static constexpr int RS16 = 1;
    unsigned char* G; const float* ssq_x;
    __device__ __forceinline__ void operator()(const Acc& acc, const Unit& u, int wr, int wc, int fr, int fq, const RsCtx& rc) const {
#pragma unroll
        for (int ai = 0; ai < 2; ++ai)
#pragma unroll
            for (int m = 0; m < 4; ++m) { const int row = EPI_ROW(u, ai, wr, m, fr); const float rs = rc.get(u.pm, ai * 128 + wr * 64 + m * 16 + fr, row);
#pragma unroll
                for (int bj = 0; bj < 2; ++bj) { f32x4 v0 = acc[ai][bj][m][0] * rs, v1 = acc[ai][bj][m][1] * rs;
#pragma unroll
                    for (int e = 0; e < 4; ++e) { v0[e] = __builtin_rintf(fast_sigmoid(v0[e]) * 255.0f); v1[e] = __builtin_rintf(fast_sigmoid(v1[e]) * 255.0f); }
                    u32x2 w; w.x = 0u; w.y = 0u;
                    w.x = __builtin_amdgcn_cvt_pk_u8_f32(v0[0], 0, w.x); w.x = __builtin_amdgcn_cvt_pk_u8_f32(v0[1], 1, w.x); w.x = __builtin_amdgcn_cvt_pk_u8_f32(v0[2], 2, w.x); w.x = __builtin_amdgcn_cvt_pk_u8_f32(v0[3], 3, w.x);
                    w.y = __builtin_amdgcn_cvt_pk_u8_f32(v1[0], 0, w.y); w.y = __builtin_amdgcn_cvt_pk_u8_f32(v1[1], 1, w.y); w.y = __builtin_amdgcn_cvt_pk_u8_f32(v1[2], 2, w.y); w.y = __builtin_amdgcn_cvt_pk_u8_f32(v1[3], 3, w.y);
                    *(u32x2*)(G + (size_t)row * DM + u.pn * 256 + bj * 128 + wc * 32 + 8 * fq) = w; } }
    }
};
struct EpiMerge {
    static constexpr int RS16 = 0;
    const unsigned char* G; bf16_t* Mg; bool first;
    __device__ __forceinline__ void operator()(const Acc& acc, const Unit& u, int wr, int wc, int fr, int fq, const RsCtx& rc) const {
#pragma unroll
        for (int ai = 0; ai < 2; ++ai)
#pragma unroll
            for (int m = 0; m < 4; ++m) { const int row = EPI_ROW(u, ai, wr, m, fr);
#pragma unroll
                for (int bj = 0; bj < 2; ++bj) { const size_t off = (size_t)row * DM + u.pn * 256 + bj * 128 + wc * 32 + 8 * fq;
                    const u32x2 gw = *(const u32x2*)(G + off); const float k255 = 1.0f / 255.0f;
                    const f32x4 g0 = (f32x4){(float)(gw.x & 0xffu), (float)((gw.x >> 8) & 0xffu), (float)((gw.x >> 16) & 0xffu), (float)(gw.x >> 24)} * k255;
                    const f32x4 g1 = (f32x4){(float)(gw.y & 0xffu), (float)((gw.y >> 8) & 0xffu), (float)((gw.y >> 16) & 0xffu), (float)(gw.y >> 24)} * k255;
                    f32x4 v0 = g0 * acc[ai][bj][m][0], v1 = g1 * acc[ai][bj][m][1];
                    if (!first) { f32x4 o0, o1; unpack8(*(const u32x4*)(Mg + off), o0, o1); v0 = v0 + o0; v1 = v1 + o1; }
                    *(u32x4*)(Mg + off) = pack8(v0, v1); }
                if (m == 3) asm volatile("" ::: "memory"); }
    }
};

struct UnitMajor6 {
    pg8::StaticOrder S;
    __device__ __forceinline__ bool next(int i, Unit& u) const { const int j = i / 6; if (!S.next(j, u)) return false; u.kind = i - 6 * j; return true; }
};
struct GSelMerge { unsigned char* ws; unsigned char* Wb;
    __device__ __forceinline__ pg8::Gemm get(int kind) const { const int b = kind >> 1; pg8::Gemm g; g.M = T; g.N = DM;
        if (kind & 1) { const size_t oa = b == 0 ? WS_CONVB : (b == 1 ? WS_CB : WS_CONVZ); g.A = (const bf16_t*)(ws + oa); g.Bt = (const bf16_t*)(Wb + O_WAO + (size_t)b * 1048576); g.K = 512; g.lda = 512; g.ldb = 512; }
        else { g.A = (const bf16_t*)(ws + WS_HB); g.Bt = (const bf16_t*)(Wb + O_WG) + (size_t)b * 1024 * 1024; g.K = DM; g.lda = DM; g.ldb = DM; }
        return g; } };
struct EpiGateMerge {
    static constexpr int RS16 = 1;
    __device__ static __forceinline__ bool rs_kind(int kind) { return (kind & 1) == 0; }
    unsigned char* G; bf16_t* Mg; const float* ssq_x;
    __device__ __forceinline__ void operator()(const Acc& acc, const Unit& u, int wr, int wc, int fr, int fq, const RsCtx& rc) const {
        int fr2 = fr, fq2 = fq; asm volatile("" : "+v"(fr2), "+v"(fq2));
        if (u.kind & 1) { EpiMerge m; m.G = G; m.Mg = Mg; m.first = (u.kind == 1); m(acc, u, wr, wc, fr2, fq2, rc); }
        else { EpiGate g; g.G = G; g.ssq_x = ssq_x; g(acc, u, wr, wc, fr2, fq2, rc); }
    }
};

__device__ __forceinline__ bf16_t* wdst(int kind, int n, unsigned char* Wb) {
    switch (kind) {
    case 0: case 2: { const int up = n >= FF, j = up ? n - FF : n; const int row = 256 * (j >> 7) + (j & 127) + (up ? 128 : 0); return (bf16_t*)(Wb + (kind == 0 ? O_GU1 : O_GU2)) + (size_t)row * 1024; }
    case 1: case 3: return (bf16_t*)(Wb + (kind == 1 ? O_DN1 : O_DN2)) + (size_t)n * FF;
    case 4: {
        bf16_t* WIN = (bf16_t*)(Wb + O_WIN); int row;
        if (n < 384) row = n;
        else if (n < 416) { const int c = n - 384; row = 384 + 2 * (c & 15) + (c >> 4); }
        else if (n < 928) row = 512 + (n - 416);
        else if (n < 1440) { const int c = n - 928; row = 1024 + 256 * (c >> 7) + (c & 127); }
        else if (n < 1952) { const int c = n - 1440; row = 1024 + 256 * (c >> 7) + 128 + (c & 127); }
        else if (n < 2464) { const int c = n - 1952, hd = c >> 6, d = c & 63; row = 2048 + hd * 64 + 2 * (d & 31) + (d >> 5); }
        else if (n < 2592) { const int c = n - 2464, hd = c >> 6, d = c & 63; row = 2560 + hd * 64 + 2 * (d & 31) + (d >> 5); }
        else if (n < 2720) return (bf16_t*)(Wb + O_WSV) + (size_t)(n - 2592) * 1024;
        else return (bf16_t*)(Wb + O_WG) + (size_t)(n - 2720) * 1024;
        return WIN + (size_t)row * 1024; }
    case 5: { const int hd = n / 96, d = n - hd * 96; int row = n; if (d >= 64) { const int c = d - 64; row = hd * 96 + 64 + 2 * (c & 15) + (c >> 4); } return (bf16_t*)(Wb + O_WUQ) + (size_t)row * 256; }
    case 6: { const int hd = n >> 7, d = n & 127; return d < 64 ? (bf16_t*)(Wb + O_WUK) + (size_t)(hd * 64 + d) * 128 : (bf16_t*)(Wb + O_WUV) + (size_t)(hd * 64 + d - 64) * 128; }
    case 7: return (bf16_t*)(Wb + O_WAO) + (size_t)n * 512;
    case 8: return (bf16_t*)(Wb + O_WBO) + (size_t)n * 512;
    case 9: return (bf16_t*)(Wb + O_WCO) + (size_t)n * 512;
    default: return (bf16_t*)(Wb + O_WO) + (size_t)n * 1024;
    }
}
__device__ __forceinline__ void conv_item(const float* W, int K, int N, int kind, int item, const float* gain, unsigned char* Wb, float* scr, int lane) {
    const int nblk = N / 32, kb = item / nblk, nb = item - kb * nblk, k0 = 64 * kb, n0 = 32 * nb;
    float wv_[32];
#pragma unroll
    for (int i = 0; i < 32; ++i) wv_[i] = W[(size_t)(k0 + 2 * i + (lane >> 5)) * N + n0 + (lane & 31)];
#pragma unroll
    for (int i = 0; i < 32; ++i) scr[(2 * i + (lane >> 5)) * 33 + (lane & 31)] = wv_[i];
    __builtin_amdgcn_s_waitcnt(0); asm volatile("" ::: "memory");
    const int c = lane & 7; float gg[8];
#pragma unroll
    for (int e = 0; e < 8; ++e) gg[e] = gain ? gain[k0 + 8 * c + e] : 1.0f;
#pragma unroll
    for (int j = 0; j < 4; ++j) { const int n = (lane >> 3) + 8 * j; const float* s = scr + (8 * c) * 33 + n;
        u32x4 o; o.x = pk2(s[0] * gg[0], s[33] * gg[1]); o.y = pk2(s[2 * 33] * gg[2], s[3 * 33] * gg[3]); o.z = pk2(s[4 * 33] * gg[4], s[5 * 33] * gg[5]); o.w = pk2(s[6 * 33] * gg[6], s[7 * 33] * gg[7]);
        *(u32x4*)(wdst(kind, n0 + n, Wb) + k0 + 8 * c) = o; }
    __builtin_amdgcn_s_waitcnt(0); asm volatile("" ::: "memory");
}

constexpr int AT_KB = 12 * 1024, AT_BUF = AT_KB + 8 * 1024;
#define AT_SB() __builtin_amdgcn_sched_barrier(0)
template <bool SWA>
__device__ __forceinline__ void attn_unit(unsigned char* lds, LAS unsigned char* ldsl, const bf16_t* Qrow, const bf16_t* Kp, int ldk, const bf16_t* Kr, const bf16_t* Vt,
                                          int ntiles, float m_init, float l_init, int qrel, bf16_t* Owave, const int tid) {
    constexpr int ND = SWA ? 4 : 6;
    constexpr float THR = 6.0f;
    const int lane = tid & 63, l32 = lane & 31, hi = lane >> 5; const int wv = __builtin_amdgcn_readfirstlane(tid >> 6);
    bf16x8 qf[ND];
#pragma unroll
    for (int d0 = 0; d0 < ND; ++d0) qf[d0] = *(const bf16x8*)(Qrow + 16 * d0 + 8 * hi);
    const int pkey = (lane & ~12) | ((lane & 4) << 1) | ((lane & 8) >> 1);
    const int koff = pkey * ldk + 8 * wv, voff = lane * T + 8 * wv, roff = pkey * 512 + 8 * (wv & 3);
    const bool do_r = (!SWA) && wv < 4;
    const int kfo = hi * 1024 + l32 * 16, vfo = AT_KB + hi * 1024 + l32 * 16;
#define AT_GLOAD(tt, boff) do { \
        __builtin_amdgcn_global_load_lds((const unsigned*)((Kp + (size_t)(tt) * 64 * ldk) + koff), (LAS unsigned*)(ldsl + (boff) + wv * 1024), 16, 0, 0); \
        __builtin_amdgcn_global_load_lds((const unsigned*)((Vt + (tt) * 64) + voff), (LAS unsigned*)(ldsl + (boff) + AT_KB + wv * 1024), 16, 0, 0); \
        if (do_r) __builtin_amdgcn_global_load_lds((const unsigned*)((Kr + (size_t)(tt) * 64 * 512) + roff), (LAS unsigned*)(ldsl + (boff) + 8192 + wv * 1024), 16, 0, 0); } while (0)
    AT_GLOAD(0, 0); AT_GLOAD(1, AT_BUF);
    asm volatile("s_waitcnt vmcnt(0)" ::: "memory");
    __syncthreads();
    f32x16 o0, o1, negm;
    float mref = SWA ? m_init : 0.f, lrun = l_init;
#pragma unroll
    for (int r = 0; r < 16; ++r) { o0[r] = 0.f; o1[r] = 0.f; negm[r] = -mref; }
    f32x16 sA0, sA1, sB0, sB1;
#define AT_MASK(S0, S1, tt) do { if (SWA) { const int kb_ = (tt) * 64 + 8 * hi - qrel; _Pragma("unroll") for (int r = 0; r < 16; ++r) { const int d_ = kb_ + 16 * (r >> 3) + (r & 7); \
        if (d_ < -128 || d_ > 128) S0[r] = -1e30f; if (d_ + 32 < -128 || d_ + 32 > 128) S1[r] = -1e30f; } } } while (0)
    {
        const unsigned char* Bn = lds;
        sA0 = __builtin_amdgcn_mfma_f32_32x32x16_bf16(*(const bf16x8*)(Bn + kfo), qf[0], negm, 0, 0, 0);
        sA1 = __builtin_amdgcn_mfma_f32_32x32x16_bf16(*(const bf16x8*)(Bn + kfo + 512), qf[0], negm, 0, 0, 0);
#pragma unroll
        for (int d0 = 1; d0 < ND; ++d0) { sA0 = __builtin_amdgcn_mfma_f32_32x32x16_bf16(*(const bf16x8*)(Bn + kfo + 2048 * d0), qf[d0], sA0, 0, 0, 0);
            sA1 = __builtin_amdgcn_mfma_f32_32x32x16_bf16(*(const bf16x8*)(Bn + kfo + 512 + 2048 * d0), qf[d0], sA1, 0, 0, 0); }
        AT_MASK(sA0, sA1, 0);
    }
    int bt = 0, bn = AT_BUF, bw = 2 * AT_BUF;
#define AT_STEP(tt, SC0, SC1, SN0, SN1, FULL) do { \
        const bool more2_ = ((tt) + 2) < ntiles; \
        if (more2_) AT_GLOAD((tt) + 2, bw); \
        float mx_; \
        { float ma = __builtin_fmaxf(__builtin_fmaxf(SC0[0], SC0[1]), SC1[0]), mb = __builtin_fmaxf(__builtin_fmaxf(SC0[2], SC0[3]), SC1[1]); \
          ma = __builtin_fmaxf(__builtin_fmaxf(ma, SC1[2]), SC1[3]); \
          _Pragma("unroll") for (int r = 4; r < 16; r += 4) { ma = __builtin_fmaxf(__builtin_fmaxf(ma, SC0[r]), SC0[r + 1]); mb = __builtin_fmaxf(__builtin_fmaxf(mb, SC0[r + 2]), SC0[r + 3]); \
              ma = __builtin_fmaxf(__builtin_fmaxf(ma, SC1[r]), SC1[r + 1]); mb = __builtin_fmaxf(__builtin_fmaxf(mb, SC1[r + 2]), SC1[r + 3]); } \
          mx_ = __builtin_fmaxf(ma, mb); \
          auto rr = __builtin_amdgcn_permlane32_swap(__float_as_uint(mx_), __float_as_uint(mx_), false, false); mx_ = __builtin_fmaxf(__uint_as_float(rr[0]), __uint_as_float(rr[1])); } \
        const bool reset_ = (!SWA) && (tt) == 0; \
        if (__any(reset_ || mx_ > THR)) { \
            const float dl = reset_ ? mx_ : __builtin_fmaxf(mx_, 0.f); \
            mref += dl; const float alpha = __builtin_amdgcn_exp2f(-dl); lrun *= alpha; \
            _Pragma("unroll") for (int r = 0; r < 16; ++r) { SC0[r] -= dl; SC1[r] -= dl; o0[r] *= alpha; o1[r] *= alpha; negm[r] = -mref; } \
        } \
        AT_SB(); \
        const unsigned char* Bn_ = lds + bn; const unsigned char* Bt_ = lds + bt; \
        if (FULL) { \
            SN0 = __builtin_amdgcn_mfma_f32_32x32x16_bf16(*(const bf16x8*)(Bn_ + kfo), qf[0], negm, 0, 0, 0); \
            SN1 = __builtin_amdgcn_mfma_f32_32x32x16_bf16(*(const bf16x8*)(Bn_ + kfo + 512), qf[0], negm, 0, 0, 0); \
            _Pragma("unroll") for (int d0 = 1; d0 < ND; ++d0) { SN0 = __builtin_amdgcn_mfma_f32_32x32x16_bf16(*(const bf16x8*)(Bn_ + kfo + 2048 * d0), qf[d0], SN0, 0, 0, 0); \
                SN1 = __builtin_amdgcn_mfma_f32_32x32x16_bf16(*(const bf16x8*)(Bn_ + kfo + 512 + 2048 * d0), qf[d0], SN1, 0, 0, 0); } \
        } \
        float ls_ = 0.f; \
        _Pragma("unroll") for (int r = 0; r < 16; ++r) { SC0[r] = __builtin_amdgcn_exp2f(SC0[r]); SC1[r] = __builtin_amdgcn_exp2f(SC1[r]); ls_ += SC0[r] + SC1[r]; } \
        lrun += ls_; \
        bf16x8 pf_[4]; \
        { u32x4 w; \
          w.x = pk2(SC0[0], SC0[1]); w.y = pk2(SC0[2], SC0[3]); w.z = pk2(SC0[4], SC0[5]); w.w = pk2(SC0[6], SC0[7]); pf_[0] = __builtin_bit_cast(bf16x8, w); \
          w.x = pk2(SC0[8], SC0[9]); w.y = pk2(SC0[10], SC0[11]); w.z = pk2(SC0[12], SC0[13]); w.w = pk2(SC0[14], SC0[15]); pf_[1] = __builtin_bit_cast(bf16x8, w); \
          w.x = pk2(SC1[0], SC1[1]); w.y = pk2(SC1[2], SC1[3]); w.z = pk2(SC1[4], SC1[5]); w.w = pk2(SC1[6], SC1[7]); pf_[2] = __builtin_bit_cast(bf16x8, w); \
          w.x = pk2(SC1[8], SC1[9]); w.y = pk2(SC1[10], SC1[11]); w.z = pk2(SC1[12], SC1[13]); w.w = pk2(SC1[14], SC1[15]); pf_[3] = __builtin_bit_cast(bf16x8, w); } \
        _Pragma("unroll") for (int g = 0; g < 4; ++g) { o0 = __builtin_amdgcn_mfma_f32_32x32x16_bf16(*(const bf16x8*)(Bt_ + vfo + 2048 * g), pf_[g], o0, 0, 0, 0); \
            o1 = __builtin_amdgcn_mfma_f32_32x32x16_bf16(*(const bf16x8*)(Bt_ + vfo + 512 + 2048 * g), pf_[g], o1, 0, 0, 0); } \
        if (FULL) { __builtin_amdgcn_sched_group_barrier(0x100, 4, 0); \
            _Pragma("unroll") for (int i_ = 0; i_ < 2 * ND; ++i_) { __builtin_amdgcn_sched_group_barrier(0x008, 1, 0); __builtin_amdgcn_sched_group_barrier(0x100, 2, 0); __builtin_amdgcn_sched_group_barrier(0x402, SWA ? 7 : 5, 0); } \
            _Pragma("unroll") for (int i_ = 0; i_ < 8; ++i_) { __builtin_amdgcn_sched_group_barrier(0x008, 1, 0); __builtin_amdgcn_sched_group_barrier(0x402, 6, 0); } } \
        AT_SB(); \
        if (FULL) AT_MASK(SN0, SN1, (tt) + 1); \
        asm volatile("s_waitcnt vmcnt(0)" ::: "memory"); \
        __syncthreads(); \
        { const int t_ = bt; bt = bn; bn = bw; bw = t_; } \
    } while (0)
    int t = 0;
    if (wv >= 4) __builtin_amdgcn_s_setprio(1);
    for (; t < ntiles - 2; t += 2) { AT_STEP(t, sA0, sA1, sB0, sB1, true); AT_STEP(t + 1, sB0, sB1, sA0, sA1, true); }
    AT_STEP(t, sA0, sA1, sB0, sB1, true);
    AT_STEP(t + 1, sB0, sB1, sA0, sA1, false);
    if (wv >= 4) __builtin_amdgcn_s_setprio(0);
#undef AT_STEP
#undef AT_MASK
#undef AT_GLOAD
    { auto rr = __builtin_amdgcn_permlane32_swap(__float_as_uint(lrun), __float_as_uint(lrun), false, false); lrun = __uint_as_float(rr[0]) + __uint_as_float(rr[1]); }
    const float inv = 1.0f / lrun;
    int tl2 = tid; asm volatile("" : "+v"(tl2));
    bf16_t* Orow = Owave + (size_t)(tl2 & 31) * 512;
#pragma unroll
    for (int rq = 0; rq < 4; ++rq) {
        u32x2 w; w.x = pk2(o0[4 * rq] * inv, o0[4 * rq + 1] * inv); w.y = pk2(o0[4 * rq + 2] * inv, o0[4 * rq + 3] * inv);
        *(u32x2*)(Orow + 8 * rq + 4 * (tl2 & 32 ? 1 : 0)) = w;
        w.x = pk2(o1[4 * rq] * inv, o1[4 * rq + 1] * inv); w.y = pk2(o1[4 * rq + 2] * inv, o1[4 * rq + 3] * inv);
        *(u32x2*)(Orow + 32 + 8 * rq + 4 * (tl2 & 32 ? 1 : 0)) = w;
    }
}

#define XB_TMO      128
#define XB_XCNT(j)  (256  + 64 * (j))
#define XB_XSUB(j)  (1280 + 64 * (j))
#define XB_XGEN(j)  (2304 + 64 * (j))
#define XB_TOP      3328
#define XB_TOPGEN   3392
#define XCD_BAR_WORDS 3456
#define XB_SPIN_CAP (1u << 22)
__device__ __forceinline__ unsigned xb_ld(unsigned* p)              { return __hip_atomic_load(p, __ATOMIC_RELAXED, __HIP_MEMORY_SCOPE_AGENT); }
__device__ __forceinline__ unsigned xb_add(unsigned* p, unsigned v) { return __hip_atomic_fetch_add(p, v, __ATOMIC_RELAXED, __HIP_MEMORY_SCOPE_AGENT); }
__device__ __forceinline__ unsigned xb_xcc_id() { return (unsigned)__builtin_amdgcn_s_getreg((3 << 11) | 20) & 0xFu; }
#define XB_SPIN(cond, bar) do { unsigned _sp = 0; while (cond) { __builtin_amdgcn_s_sleep(1); \
    if ((++_sp & 255u) == 0u) { if (xb_ld(&(bar)[XB_TMO])) break; if (_sp > XB_SPIN_CAP) { atomicAdd(&(bar)[XB_TMO], 1u); break; } } } } while (0)
struct XcdBarrier { unsigned* bar; unsigned x; volatile LAS unsigned* st; };
__device__ __forceinline__ XcdBarrier xcd_barrier_post(unsigned* bar, volatile LAS unsigned* st) {
    XcdBarrier b; b.bar = bar; b.x = xb_xcc_id(); b.st = st;
    if (threadIdx.x == 0) (void)xb_add(&bar[XB_XCNT(b.x)], 1u);
    return b;
}
__device__ __forceinline__ void xcd_barrier_complete(unsigned* bar, unsigned x, unsigned& nloc, unsigned& nx) {
    const unsigned G = gridDim.x * gridDim.y * gridDim.z;
    unsigned sum, cnt, mine, sp = 0u;
    for (;;) {
        sum = 0u; cnt = 0u; mine = 0u;
#pragma unroll
        for (unsigned j = 0; j < 16; ++j) { const unsigned c = xb_ld(&bar[XB_XCNT(j)]); sum += c; cnt += (c > 0u) ? 1u : 0u; mine = (j == x) ? c : mine; }
        if (sum == G) break;
        __builtin_amdgcn_s_sleep(1);
        if ((++sp & 255u) == 0u) { if (xb_ld(&bar[XB_TMO])) break; if (sp > XB_SPIN_CAP) { atomicAdd(&bar[XB_TMO], 1u); break; } }
    }
    nloc = mine > 0u ? mine : 1u; nx = cnt > 0u ? cnt : 1u;
}
__device__ __forceinline__ void xcd_barrier(const XcdBarrier& b) {
    asm volatile("s_waitcnt vmcnt(0)" ::: "memory");
    __syncthreads();
    if (threadIdx.x == 0) {
        unsigned* bar = b.bar;
        __builtin_amdgcn_s_waitcnt(0);
        unsigned nloc = b.st[0], nx = b.st[1];
        if (nloc == 0u) { xcd_barrier_complete(bar, b.x, nloc, nx); b.st[0] = nloc; b.st[1] = nx; }
        const unsigned old = xb_add(&bar[XB_XSUB(b.x)], 1u);
        const unsigned gen = old / nloc;
        if (old + 1u == (gen + 1u) * nloc) {
            __builtin_amdgcn_fence(__ATOMIC_RELEASE, "agent");
            asm volatile("s_waitcnt vmcnt(0)" ::: "memory");
            const unsigned og = xb_add(&bar[XB_TOP], 1u);
            const unsigned tg = og / nx;
            if (og + 1u == (tg + 1u) * nx) xb_add(&bar[XB_TOPGEN], 1u);
            else XB_SPIN(xb_ld(&bar[XB_TOPGEN]) == tg, bar);
            __builtin_amdgcn_fence(__ATOMIC_ACQUIRE, "agent");
            xb_add(&bar[XB_XGEN(b.x)], 1u);
            asm volatile("s_waitcnt vmcnt(0)" ::: "memory");
        } else {
            XB_SPIN(xb_ld(&bar[XB_XGEN(b.x)]) == gen, bar);
            __builtin_amdgcn_fence(__ATOMIC_ACQUIRE, "agent");
            asm volatile("s_waitcnt vmcnt(0)" ::: "memory");
        }
    }
    __syncthreads();
}

struct Args { const float* in[21]; float* out; unsigned char* ws; int ph_lo, ph_hi; };

__global__ void __launch_bounds__(512, 2) mk_fwd(Args a) {
    extern __shared__ __attribute__((aligned(16))) unsigned char lds[];
    cg::grid_group grid = cg::this_grid();
    volatile LAS unsigned* bst = (volatile LAS unsigned*)((LAS unsigned char*)lds + 131072 + 256);
    if (threadIdx.x < 2) bst[threadIdx.x] = 0u;
    __syncthreads();
    XcdBarrier xbar; xbar.bar = (unsigned*)(a.ws + WS_BAR); xbar.x = 0; xbar.st = bst;
    if (a.ph_hi - a.ph_lo > 1) xbar = xcd_barrier_post((unsigned*)(a.ws + WS_BAR), bst);
    bool dup_done = false;
#pragma nounroll
    for (int ph = a.ph_lo; ph < a.ph_hi; ++ph) {
            typedef const __attribute__((address_space(4))) Args* KArgs;
            KArgs ap = (KArgs)__builtin_amdgcn_kernarg_segment_ptr(); asm volatile("" : "+s"(ap));
            int tid = threadIdx.x; asm volatile("" : "+v"(tid));
            const int wave = __builtin_amdgcn_readfirstlane(tid >> 6);
#define LOCAL_LANE int tl_ = tid; asm volatile("" : "+v"(tl_)); const int lane = tl_ & 63
        const int G = gridDim.x, bx = blockIdx.x;
        const int vcu = (G % 8 == 0) ? (bx % 8) * (G / 8) + bx / 8 : bx;
        const int gw = vcu * 8 + wave, NGW = G * 8;
        unsigned char* ws = ap->ws; asm volatile("" : "+s"(ws));
        float* X = ap->out; asm volatile("" : "+s"(X));
        float* ssq_q = (float*)(ws + WS_SSQQ); float* ssq_kv = (float*)(ws + WS_SSQKV); float* ssq_x = (float*)(ws + WS_SSQX);
        float* TABM = (float*)(ws + WS_TABM); float* TABS = (float*)(ws + WS_TABS);
        unsigned char* Wb = ws + WS_W;
        bf16_t* HB = (bf16_t*)(ws + WS_HB); bf16_t* ACT = (bf16_t*)(ws + WS_ACT); bf16_t* LAT = (bf16_t*)(ws + WS_LAT);
        bf16_t* CONVB = (bf16_t*)(ws + WS_CONVB); bf16_t* CONVZ = (bf16_t*)(ws + WS_CONVZ); bf16_t* SWAQK = (bf16_t*)(ws + WS_SWAQK);
        bf16_t* SWAVT = (bf16_t*)(ws + WS_SWAVT); bf16_t* CB = (bf16_t*)(ws + WS_CB); bf16_t* Q = (bf16_t*)(ws + WS_Q);
        bf16_t* KNOPE = (bf16_t*)(ws + WS_KNOPE); bf16_t* VT = (bf16_t*)(ws + WS_VT); bf16_t* GB = (bf16_t*)(ws + WS_G);
        bf16_t* MERGED = (bf16_t*)(ws + WS_MERGED); bf16_t* OA = CONVB; bf16_t* OC = CONVZ;
        LAS unsigned char* ldsl = (LAS unsigned char*)lds;

        const int layer = ph / 21, sub = ph - layer * 21;
        bool sync_after = true;
        if (ph == 84) {
            if (PON(48)) {
            LOCAL_LANE;
            const float* gf = ap->in[20];
            for (int row = gw; row < T; row += NGW) {
                f32x4* xr = (f32x4*)(X + (size_t)row * DM) + lane; const u32x2* xb = (const u32x2*)(HB + (size_t)row * DM) + lane; f32x4 v[4]; float s = 0.f;
#pragma unroll
                for (int j = 0; j < 4; ++j) { const u32x2 w = xb[64 * j]; v[j] = (f32x4){bflo(w.x), bfhi(w.x), bflo(w.y), bfhi(w.y)}; s += (v[j].x * v[j].x + v[j].y * v[j].y) + (v[j].z * v[j].z + v[j].w * v[j].w); }
                const float rs = rsqrtf(wave_sum(s) * (1.0f / DM) + EPS);
#pragma unroll
                for (int j = 0; j < 4; ++j) { const f32x4 g4 = ((const f32x4*)gf)[lane + 64 * j]; xr[64 * j] = v[j] * rs * g4; }
            }
            }
        } else if (sub == 3 || sub == 18) {
            continue;
        } else if (sub == 0 && PON(0)) {
            LOCAL_LANE;
            {
                if (layer == 0) {
                    for (int idx = bx * 512 + tid; idx < 8192 * 48; idx += G * 512) { const int pos = idx / 48, j = idx - pos * 48;
                        const bool ism = j < 16; const int jj = ism ? j : j - 16;
                        const float inv = exp2f(-(float)jj * (ism ? (1.0f / 16.0f) : (1.0f / 32.0f)) * 13.287712379549449f);
                        const float ang = (float)pos * inv; float* dst = ism ? TABM + ((size_t)pos * 16 + jj) * 2 : TABS + ((size_t)pos * 32 + jj) * 2;
                        dst[0] = cosf(ang); dst[1] = sinf(ang); }
                }
                float* scr = (float*)(lds + wave * 8448);
                const size_t L = (size_t)layer;
                for (int it = gw; it < 12784; it += NGW) {
                    int r = it;
                    if (r < 2816) { conv_item(ap->in[3] + L * 1024 * 5632, 1024, 5632, 0, r, ap->in[2] + L * 1024, Wb, scr, lane); continue; } r -= 2816;
                    if (r < 2816) { conv_item(ap->in[18] + L * 1024 * 5632, 1024, 5632, 2, r, ap->in[17] + L * 1024, Wb, scr, lane); continue; } r -= 2816;
                    if (r < 2896) { conv_item(ap->in[6] + L * 1024 * 5792, 1024, 5792, 4, r, ap->in[5] + L * 1024, Wb, scr, lane); continue; } r -= 2896;
                    if (r < 1408) { conv_item(ap->in[4] + L * 2816 * 1024, 2816, 1024, 1, r, nullptr, Wb, scr, lane); continue; } r -= 1408;
                    if (r < 1408) { conv_item(ap->in[19] + L * 2816 * 1024, 2816, 1024, 3, r, nullptr, Wb, scr, lane); continue; } r -= 1408;
                    if (r < 512) { conv_item(ap->in[16] + L * 1024 * 1024, 1024, 1024, 10, r, nullptr, Wb, scr, lane); continue; } r -= 512;
                    if (r < 256) { conv_item(ap->in[11] + L * 512 * 1024, 512, 1024, 7, r, nullptr, Wb, scr, lane); continue; } r -= 256;
                    if (r < 256) { conv_item(ap->in[13] + L * 512 * 1024, 512, 1024, 8, r, nullptr, Wb, scr, lane); continue; } r -= 256;
                    if (r < 256) { conv_item(ap->in[15] + L * 512 * 1024, 512, 1024, 9, r, nullptr, Wb, scr, lane); continue; } r -= 256;
                    if (r < 96) { conv_item(ap->in[8] + L * 256 * 768, 256, 768, 5, r, ap->in[7] + L * 256, Wb, scr, lane); continue; } r -= 96;
                    conv_item(ap->in[10] + L * 128 * 1024, 128, 1024, 6, r, ap->in[9] + L * 128, Wb, scr, lane);
                }
            }
            if (layer == 0) {
                for (int row = gw; row < T; row += NGW) {
                    const float* src = row < TP ? ap->in[0] + (size_t)row * DM : ap->in[1] + (size_t)(row - TP) * DM;
                    const f32x4* xr = (const f32x4*)src + lane; f32x4 v[4]; float sq = 0.f;
#pragma unroll
                    for (int j = 0; j < 4; ++j) { v[j] = xr[64 * j]; sq += (v[j].x * v[j].x + v[j].y * v[j].y) + (v[j].z * v[j].z + v[j].w * v[j].w); }
                    sq = wave_sum(sq);
                    u32x2* o8 = (u32x2*)(HB + (size_t)row * DM) + lane;
#pragma unroll
                    for (int j = 0; j < 4; ++j) { u32x2 w; w.x = pk2(v[j].x, v[j].y); w.y = pk2(v[j].z, v[j].w); o8[64 * j] = w; }
                    if (lane < 16) ssq_x[(size_t)row * 16 + lane] = lane == 0 ? sq : 0.f;
                }
            }
        } else if ((sub == 1 || sub == 19) && PON(1)) {
            pg8::Gemm g{HB, (const bf16_t*)(Wb + (sub == 1 ? O_GU1 : O_GU2)), T, 2 * FF, DM, DM, DM}; pg8::StaticOrder S; S.init(T, 2 * FF, G, bx);
            EpiSwiGLU E{ACT, ssq_x};
            pg8::gemm_phase(ldsl, g, S, E, tid);
        } else if ((sub == 2 || sub == 20 || sub == 17) && PON(2)) {
            const bool wo = (sub == 17);
            const bf16_t* Aop = wo ? MERGED : ACT; const bf16_t* Bop = (const bf16_t*)(Wb + (sub == 2 ? O_DN1 : sub == 20 ? O_DN2 : O_WO));
            int Kd = wo ? DM : FF; asm volatile("" : "+s"(Kd));
            float alpha = wo ? 1.0f : 0.5f; asm volatile("" : "+v"(alpha));
            pg8::Gemm g; g.A = Aop; g.Bt = Bop; g.M = T; g.N = DM; g.K = Kd; g.lda = Kd; g.ldb = Kd;
            pg8::StaticOrder S; S.init(T, DM, G, bx);
            EpiResid E; E.X = X; E.alpha = alpha; E.XB = HB; E.ssq_x = ssq_x;
            pg8::gemm_phase(ldsl, g, S, E, tid);
        } else if (sub == 4 && PON(4)) {
            pg8::Gemm g{HB, (const bf16_t*)(Wb + O_WIN), T, 2816, DM, DM, DM}; pg8::StaticOrder S; S.init(T, 2816, G, bx);
            EpiWin E{LAT, CONVB, CONVZ, SWAQK, ssq_q, ssq_kv, TABM, TABS, ssq_x};
            pg8::gemm_phase(ldsl, g, S, E, tid);
            sync_after = false;
        } else if ((sub == 5 || sub == 9) && PON(5)) {
            const bool sv = sub == 5;
            pg8::Gemm g{(const bf16_t*)(Wb + (sv ? O_WSV : O_WUV)), sv ? HB : LAT + 256, sv ? 256 : 512, T, sv ? DM : 128, sv ? DM : 128, sv ? DM : 512};
            pg8::StaticOrder S; if (sv) S.init(256, T, 128, bx >= G - 128 ? bx - (G - 128) : (1 << 24)); else S.init(512, T, G, bx);
            EpiColScaleT E{sv ? SWAVT : VT, sv ? ssq_x : ssq_kv, sv ? 128 : 512, sv};
            pg8::gemm_phase(ldsl, g, S, E, tid);
        } else if (sub == 6 && PON(6)) {
            LOCAL_LANE;
            const float* cw = ap->in[12] + (size_t)layer * 1536; float w0[8], w1[8], w2[8];
#pragma unroll
            for (int e = 0; e < 8; ++e) { w0[e] = cw[8 * lane + e]; w1[e] = cw[512 + 8 * lane + e]; w2[e] = cw[1024 + 8 * lane + e]; }
            for (int row = gw; row < T; row += NGW) {
                const int pos = tok_pos(row), S_ = row < TP ? 4096 : 8192;
                const u32x4 zc = *(const u32x4*)(CONVZ + (size_t)row * 512 + 8 * lane), bb = *(const u32x4*)(CONVB + (size_t)row * 512 + 8 * lane);
                u32x4 zp = (u32x4){0u, 0u, 0u, 0u}, zn = zp;
                if (pos > 0) zp = *(const u32x4*)(CONVZ + (size_t)(row - 1) * 512 + 8 * lane);
                if (pos < S_ - 1) zn = *(const u32x4*)(CONVZ + (size_t)(row + 1) * 512 + 8 * lane);
                f32x4 c0, c1, p0, p1, n0, n1, b0, b1; unpack8(zc, c0, c1); unpack8(zp, p0, p1); unpack8(zn, n0, n1); unpack8(bb, b0, b1);
                f32x4 y0, y1;
#pragma unroll
                for (int e = 0; e < 4; ++e) { y0[e] = b0[e] * (w0[e] * p0[e] + w1[e] * c0[e] + w2[e] * n0[e]); y1[e] = b1[e] * (w0[4 + e] * p1[e] + w1[4 + e] * c1[e] + w2[4 + e] * n1[e]); }
                *(u32x4*)(CB + (size_t)row * 512 + 8 * lane) = pack8(y0, y1);
            }
            sync_after = false;
        } else if (sub == 7 && PON(7)) {
            pg8::Gemm g{LAT, (const bf16_t*)(Wb + O_WUQ), T, 768, 256, 512, 256}; pg8::StaticOrder S; S.init(T, 768, G, bx);
            EpiQ E{Q, ssq_q, TABM};
            pg8::gemm_phase(ldsl, g, S, E, tid);
            sync_after = false;
        } else if (sub == 8 && PON(8)) {
            pg8::Gemm g{LAT + 256, (const bf16_t*)(Wb + O_WUK), T, 512, 128, 512, 128}; pg8::StaticOrder S; S.init(T, 512, G, bx);
            EpiRowScale E{KNOPE, ssq_kv};
            pg8::gemm_phase(ldsl, g, S, E, tid);
            sync_after = false;
        } else if (sub == 10 && PON(10)) {
            LOCAL_LANE;
            const int wv = wave, l32 = lane & 31;
            for (int u = vcu; u < 512; u += G) {
                const int bh = u >> 5, qb = u & 31, b = bh >> 3, h = bh & 7; const size_t base = TP + (size_t)b * 8192; const size_t qrow = base + 256 * qb + 32 * wv + l32;
                attn_unit<false>(lds, ldsl, Q + qrow * 768 + h * 96, KNOPE + base * 512 + h * 64, 512, LAT + base * 512 + 384, VT + (size_t)(h * 64) * T + base, 128, -1e30f, 0.f, 0, OA + (qrow - l32) * 512 + h * 64, tid);
            }
            for (int u = vcu; u < 512; u += G) {
                const int bh = u >> 4, qb = u & 15, b = bh >> 3, h = bh & 7; const size_t base = (size_t)b * 4096; const size_t qrow = base + 256 * qb + 32 * wv + l32;
                attn_unit<false>(lds, ldsl, Q + qrow * 768 + h * 96, KNOPE + base * 512 + h * 64, 512, LAT + base * 512 + 384, VT + (size_t)(h * 64) * T + base, 64, -1e30f, 0.f, 0, OA + (qrow - l32) * 512 + h * 64, tid);
            }
            const float* sink = ap->in[14] + (size_t)layer * 8;
            for (int u = vcu * 4; u < 1024; u += G * 4)
                for (int k = 0; k < 4; ++k) {
                    const int uu = u + k, hp = uu & 1, g2 = (uu >> 1) & 1, nblk = uu >> 2; const int row0 = nblk * 128;
                    const int S_ = row0 < TP ? 4096 : 8192; const int base = row0 < TP ? (row0 & ~4095) : TP + ((row0 - TP) & ~8191);
                    const int n = (row0 - base) >> 7; const int t_lo = n > 0 ? 2 * (n - 1) : 0; int t_hi = 2 * (n + 2); if (t_hi > S_ / 64) t_hi = S_ / 64;
                    const int head = 4 * g2 + 2 * hp + (wv >> 2); const int qpos = 128 * n + 32 * (wv & 3) + l32; const size_t qrow = (size_t)base + qpos; const size_t kbase = (size_t)base + 64 * t_lo;
                    attn_unit<true>(lds, ldsl, SWAQK + qrow * 768 + head * 64, SWAQK + kbase * 768 + 512 + g2 * 64, 768, SWAQK, SWAVT + (size_t)(g2 * 64) * T + kbase, t_hi - t_lo,
                                    sink[head] * LOG2E, (lane >> 5) == 0 ? 1.0f : 0.0f, qpos - 64 * t_lo, OC + (qrow - l32) * 512 + head * 64, tid);
                }
        } else if (sub == 11 && PON(11)) {
            UnitMajor6 S; S.S.init(T, DM, G, bx);
            GSelMerge GS{ws, Wb};
            EpiGateMerge E{(unsigned char*)GB, MERGED, ssq_x};
            pg8::gemm_multi(ldsl, GS, S, E, tid);
        } else if (sub >= 12 && sub <= 16) {
            continue;
        }
        if (DUP_SUB >= 0 && sub == DUP_SUB && ph != 84 && !dup_done) { dup_done = true; --ph; xcd_barrier(xbar); continue; }
        dup_done = false;
        if (sync_after && ph + 1 < a.ph_hi) { if (ph == a.ph_lo) grid.sync(); else xcd_barrier(xbar); }
    }
}

extern "C" void kernel_launch(void* const* d_in, const int* in_sizes, int n_in, void* d_out, int out_size, void* d_ws, size_t ws_size, hipStream_t stream) {
    static int grid = 0;
    if (grid == 0) {
        if (n_in != 21 || out_size != T * DM || ws_size < WS_END) { fprintf(stderr, "kernel_launch: unexpected problem: n_in %d out %d ws %zu (need %zu)\n", n_in, out_size, ws_size, (size_t)WS_END); grid = -1; return; }
        int dev = 0, cus = 0, per_cu = 0;
        hipGetDevice(&dev); hipDeviceGetAttribute(&cus, hipDeviceAttributeMultiprocessorCount, dev);
        if (hipFuncSetAttribute((const void*)mk_fwd, hipFuncAttributeMaxDynamicSharedMemorySize, LDS_BYTES) != hipSuccess) { fprintf(stderr, "kernel_launch: hipFuncSetAttribute failed\n"); grid = -1; return; }
        if (hipOccupancyMaxActiveBlocksPerMultiprocessor(&per_cu, (const void*)mk_fwd, 512, LDS_BYTES) != hipSuccess || per_cu < 1) { fprintf(stderr, "kernel_launch: occupancy query says %d\n", per_cu); per_cu = 1; }
        (void)hipGetLastError();
        grid = cus;
    }
    if (grid < 0) return;
    Args a{};
    for (int i = 0; i < 21; ++i) a.in[i] = (const float*)d_in[i];
    a.out = (float*)d_out; a.ws = (unsigned char*)d_ws;
#if ONE_LAUNCH
    if (hipMemsetAsync((char*)d_ws + WS_BAR, 0, BAR_BYTES, stream) != hipSuccess) { fprintf(stderr, "kernel_launch: memset failed\n"); return; }
    a.ph_lo = 0; a.ph_hi = NPH;
    void* args[] = {&a};
    hipError_t e = hipLaunchCooperativeKernel((const void*)mk_fwd, dim3(grid), dim3(512), args, LDS_BYTES, stream);
    if (e != hipSuccess) fprintf(stderr, "kernel_launch: cooperative launch failed: %s (grid %d)\n", hipGetErrorString(e), grid);
#else
    for (int ph = 0; ph < NPH; ++ph) { a.ph_lo = ph; a.ph_hi = ph + 1; hipLaunchKernelGGL(mk_fwd, dim3(grid), dim3(512), LDS_BYTES, stream, a); }
#endif
}
```

```cpp
#include <hip/hip_runtime.h>
#include <hip/hip_cooperative_groups.h>
#include <cstdio>
#include <cstdint>
namespace cg = cooperative_groups;

#ifndef ONE_LAUNCH
#define ONE_LAUNCH 1
#endif

#ifndef DUP_SUB
#define DUP_SUB -1
#endif
#ifndef ONLY
#define ONLY -1
#endif
#define PON(k) (ONLY < 0 || ONLY == (k))
#define LAS __attribute__((address_space(3)))
typedef unsigned short bf16_t;
typedef short bf16x8 __attribute__((ext_vector_type(8)));
typedef float f32x4 __attribute__((ext_vector_type(4)));
typedef float f32x16 __attribute__((ext_vector_type(16)));
typedef unsigned u32x4 __attribute__((ext_vector_type(4)));
typedef unsigned u32x2 __attribute__((ext_vector_type(2)));
typedef float f32x2_t __attribute__((ext_vector_type(2)));
typedef __bf16 bf16x2_t __attribute__((ext_vector_type(2)));

constexpr int T = 32768, TP = 16384, DM = 1024, FF = 2816;
constexpr float EPS = 1e-6f, LOG2E = 1.4426950408889634f;
constexpr int NPH = 85;

constexpr size_t MiB = 1u << 20;
constexpr size_t WS_SSQQ = 0, WS_SSQKV = 524288;
constexpr size_t WS_TABM = 1 * MiB, WS_TABS = 2 * MiB;
constexpr size_t WS_W = 4 * MiB;
constexpr size_t WS_BAR = 55 * MiB, BAR_BYTES = 16384;
constexpr size_t WS_HB = 56 * MiB;
constexpr size_t WS_BIG = 120 * MiB;
constexpr size_t WS_ACT = WS_BIG;
constexpr size_t WS_LAT = WS_BIG;
constexpr size_t WS_CONVB = WS_BIG + 32 * MiB;
constexpr size_t WS_CONVZ = WS_BIG + 64 * MiB;
constexpr size_t WS_SWAQK = WS_BIG + 96 * MiB;
constexpr size_t WS_SWAVT = WS_BIG + 144 * MiB;
constexpr size_t WS_CB = WS_BIG + 152 * MiB;
constexpr size_t WS_Q = WS_BIG + 184 * MiB;
constexpr size_t WS_KNOPE = WS_BIG + 232 * MiB;
constexpr size_t WS_VT = WS_BIG + 264 * MiB;
constexpr size_t WS_G = WS_BIG + 296 * MiB;
constexpr size_t WS_MERGED = WS_Q;
constexpr size_t WS_SSQX = WS_BIG + 360 * MiB;
constexpr size_t WS_END = WS_BIG + 362 * MiB;
constexpr size_t O_GU1 = 0, O_DN1 = 11534336, O_GU2 = 17301504, O_DN2 = 28835840, O_WIN = 34603008, O_WG = 40370176, O_WSV = 46661632,
                 O_WUQ = 47185920, O_WUK = 47579136, O_WUV = 47710208, O_WAO = 47841280, O_WBO = 48889856, O_WCO = 49938432, O_WO = 50987008;

constexpr int LDS_BYTES = 147456;

__device__ __forceinline__ unsigned pk2(float lo, float hi) { f32x2_t v = {lo, hi}; bf16x2_t b = __builtin_convertvector(v, bf16x2_t); return __builtin_bit_cast(unsigned, b); }
__device__ __forceinline__ float bflo(unsigned u) { return __uint_as_float(u << 16); }
__device__ __forceinline__ float bfhi(unsigned u) { return __uint_as_float(u & 0xffff0000u); }
__device__ __forceinline__ u32x4 pack8(f32x4 a, f32x4 b) { u32x4 w; w.x = pk2(a[0], a[1]); w.y = pk2(a[2], a[3]); w.z = pk2(b[0], b[1]); w.w = pk2(b[2], b[3]); return w; }
__device__ __forceinline__ void unpack8(u32x4 w, f32x4& a, f32x4& b) { a = (f32x4){bflo(w.x), bfhi(w.x), bflo(w.y), bfhi(w.y)}; b = (f32x4){bflo(w.z), bfhi(w.z), bflo(w.w), bfhi(w.w)}; }
__device__ __forceinline__ float wave_sum(float v) {
#pragma unroll
    for (int o = 1; o < 64; o <<= 1) v += __shfl_xor(v, o);
    return v;
}
__device__ __forceinline__ float fast_sigmoid(float x) { return __builtin_amdgcn_rcpf(1.0f + __builtin_amdgcn_exp2f(-x * LOG2E)); }
__device__ __forceinline__ int tok_pos(int row) { return row < TP ? (row & 4095) : (row & 8191); }
__device__ __forceinline__ void rope8(f32x4& v0, f32x4& v1, const float* tab) {
    const f32x4 t0 = *(const f32x4*)tab, t1 = *(const f32x4*)(tab + 4);
    float a, b;
    a = v0[0] * t0[0] - v0[1] * t0[1]; b = v0[1] * t0[0] + v0[0] * t0[1]; v0[0] = a; v0[1] = b;
    a = v0[2] * t0[2] - v0[3] * t0[3]; b = v0[3] * t0[2] + v0[2] * t0[3]; v0[2] = a; v0[3] = b;
    a = v1[0] * t1[0] - v1[1] * t1[1]; b = v1[1] * t1[0] + v1[0] * t1[1]; v1[0] = a; v1[1] = b;
    a = v1[2] * t1[2] - v1[3] * t1[3]; b = v1[3] * t1[2] + v1[2] * t1[3]; v1[2] = a; v1[3] = b;
}

__device__ __forceinline__ float row_rs16(const float* ssq_x, int row) {
    const f32x4* p = (const f32x4*)(ssq_x + (size_t)row * 16); const f32x4 a = p[0], b = p[1], c = p[2], d = p[3];
    return rsqrtf((((a[0] + a[1]) + (a[2] + a[3])) + ((b[0] + b[1]) + (b[2] + b[3])) + ((c[0] + c[1]) + (c[2] + c[3])) + ((d[0] + d[1]) + (d[2] + d[3]))) * (1.0f / DM) + EPS);
}

struct RsCtx { const LAS float* t; int p0, p1; const float* ssq_x;
    __device__ __forceinline__ float get(int key, int idx, int row) const { return key == p0 ? t[idx] : key == p1 ? t[256 + idx] : row_rs16(ssq_x, row); } };

namespace pg8 {
constexpr int BM = 256, BK = 64, HALF = 128, HTB = HALF * BK * 2, STAGE_BYTES = 8 * HTB, NXCD = 8, WGM = 8;
__host__ __device__ __forceinline__ int lds_byte(int r, int c) { const int st = (r >> 4) * 2 + (c >> 5), rr = r & 15, cc = c & 31, ob = rr * 64 + cc * 2; return st * 1024 + (ob ^ (((ob >> 9) & 1) << 5)); }
__host__ __device__ __forceinline__ void stage_rc(int b, int& R, int& C) { const int st = b / 1024, sb = b % 1024, swz = sb ^ (((sb >> 9) & 1) << 5); R = (st >> 1) * 16 + swz / 64; C = (st & 1) * 32 + (swz % 64) / 2; }
__host__ __device__ __forceinline__ int perm32(int rho) { const int n = rho >> 4, i = rho & 15; return 8 * (i >> 2) + 4 * n + (i & 3); }

struct Unit { int pm, pn, kind; };
struct Gemm { const bf16_t* A; const bf16_t* Bt; int M, N, K, lda, ldb; };

struct StaticOrder {
    int nM, nN, nwg, G, c;
    __host__ __device__ void init(int M, int N, int G_, int c_) { nM = M / BM; nN = N / BM; nwg = nM * nN; G = G_; c = c_; }
    __host__ __device__ bool next(int i, Unit& u) const {
        const long L = (long)i * G + c; if (L >= nwg) return false;
        int wgid = (int)L; { const int q = nwg / NXCD, r = nwg % NXCD, xcd = wgid % NXCD, off = wgid / NXCD; wgid = (xcd < r ? xcd * (q + 1) : r * (q + 1) + (xcd - r) * q) + off; }
        const int nig = WGM * nN, gid = wgid / nig, fm = gid * WGM, gsz = (nM - fm) < WGM ? (nM - fm) : WGM;
        u.pm = fm + ((wgid % nig) % gsz); u.pn = (wgid % nig) / gsz; u.kind = 0; return true;
    }
};

template <class Epi, class Sched>
__device__ __forceinline__ void gemm_phase(LAS unsigned char* lds, const Gemm g, const Sched S, const Epi E, const int tid) {
    const int wid = __builtin_amdgcn_readfirstlane(tid >> 6), lane = tid & 63, wr = wid >> 2, wc = wid & 3, fr = lane & 15, fq = lane >> 4;
    int K = g.K; asm volatile("" : "+s"(K)); const int nt = K / BK;
    unsigned voffA[2], voffB[2];
#pragma unroll
    for (int i = 0; i < 2; ++i) { int R, C; stage_rc(tid * 16 + i * 8192, R, C); const int Rb = (R & ~31) + perm32(R & 31);
        voffA[i] = (unsigned)(R * g.lda + C) * 2u; voffB[i] = (unsigned)(Rb * g.ldb + C) * 2u; }
    const size_t kstep = (size_t)(BK * 2);
    const size_t hstepA = (size_t)HALF * g.lda * 2, hstepB = (size_t)HALF * g.ldb * 2;
    const size_t tstepA = 2 * hstepA, tstepB = 2 * hstepB;
    const unsigned ldsw = (unsigned)wid * 1024u;
    const int aoff = lds_byte(wr * 64 + fr, fq * 8), boff = lds_byte(wc * 32 + fr, fq * 8);
#define PG8_SA(b, h) (((b) * 2 + (h)) * HTB)
#define PG8_SB(b, h) ((4 + (b) * 2 + (h)) * HTB)
#define PG8_STAGE(bufoff, gbase, voff) do { _Pragma("unroll") for (int _i = 0; _i < 2; ++_i) \
        __builtin_amdgcn_global_load_lds((const unsigned*)((const char*)(gbase) + (voff)[_i]), (LAS unsigned*)(lds + (bufoff) + ldsw + _i * 8192), 16, 0, 0); } while (0)
#define PG8_LDA(dst, b, h) do { _Pragma("unroll") for (int m = 0; m < 4; ++m) _Pragma("unroll") for (int k = 0; k < 2; ++k) dst[m][k] = *(const LAS bf16x8*)(lds + PG8_SA(b, h) + aoff + m * 2048 + k * 1024); } while (0)
#define PG8_LDB(dst, b, h) do { _Pragma("unroll") for (int n = 0; n < 2; ++n) _Pragma("unroll") for (int k = 0; k < 2; ++k) dst[n][k] = *(const LAS bf16x8*)(lds + PG8_SB(b, h) + boff + n * 2048 + k * 1024); } while (0)
#define PG8_MMA(ai, bj, At, Bt) do { __builtin_amdgcn_s_setprio(1); _Pragma("unroll") for (int m = 0; m < 4; ++m) _Pragma("unroll") for (int n = 0; n < 2; ++n) _Pragma("unroll") for (int k = 0; k < 2; ++k) \
        acc[ai][bj][m][n] = __builtin_amdgcn_mfma_f32_16x16x32_bf16(Bt[n][k], At[m][k], acc[ai][bj][m][n], 0, 0, 0); __builtin_amdgcn_s_setprio(0); } while (0)
#define PG8_WAIT_V(n) asm volatile("s_waitcnt vmcnt(" #n ")" ::: "memory")
#define PG8_WAIT_L(n) asm volatile("s_waitcnt lgkmcnt(" #n ")" ::: "memory")
#define PG8_BAR __builtin_amdgcn_s_barrier()
#define PG8_SCHED __builtin_amdgcn_sched_barrier(0)
    Unit cur, nxt; int ui = 0;
    if (!S.next(0, cur)) return;
    RsCtx rc; rc.t = (const LAS float*)(lds + 132096); rc.p0 = -1; rc.p1 = -1; rc.ssq_x = nullptr;
    if constexpr (Epi::RS16 != 0) {
        rc.ssq_x = E.ssq_x; Unit uu;
        for (int i = 0; S.next(i, uu); ++i) { const int key = Epi::RS16 == 2 ? uu.pn : uu.pm; if (key != rc.p0 && key != rc.p1) { if (rc.p0 < 0) rc.p0 = key; else if (rc.p1 < 0) rc.p1 = key; } }
        const int key = tid < 256 ? rc.p0 : rc.p1;
        if (key >= 0) ((LAS float*)(lds + 132096))[tid] = row_rs16(E.ssq_x, key * 256 + (tid & 255));
        asm volatile("s_waitcnt vmcnt(0) lgkmcnt(0)" ::: "memory"); __builtin_amdgcn_s_barrier(); asm volatile("" ::: "memory");
    }
    f32x4 acc[2][2][4][2];
#pragma unroll
    for (int a = 0; a < 2; ++a)
#pragma unroll
        for (int b = 0; b < 2; ++b)
#pragma unroll
            for (int m = 0; m < 4; ++m)
#pragma unroll
                for (int n = 0; n < 2; ++n) acc[a][b][m][n] = (f32x4){0.f, 0.f, 0.f, 0.f};
    bf16x8 At[4][2], B0[2][2], B1[2][2];
    const char* cA = (const char*)g.A + (size_t)cur.pm * tstepA; const char* cB = (const char*)g.Bt + (size_t)cur.pn * tstepB;
    PG8_STAGE(PG8_SB(0, 0), cB, voffB); PG8_STAGE(PG8_SB(0, 1), cB + hstepB, voffB); PG8_STAGE(PG8_SA(0, 0), cA, voffA); PG8_STAGE(PG8_SA(0, 1), cA + hstepA, voffA);
    if (wr == 1) PG8_BAR;
    PG8_WAIT_V(2); PG8_BAR;
    PG8_STAGE(PG8_SB(1, 0), cB + kstep, voffB); PG8_STAGE(PG8_SA(1, 0), cA + kstep, voffA); PG8_STAGE(PG8_SB(1, 1), cB + hstepB + kstep, voffB);
    PG8_WAIT_V(6); PG8_BAR;
    for (;;) {
        const bool has_next = S.next(ui + 1, nxt);
        const char* nA = has_next ? (const char*)g.A + (size_t)nxt.pm * tstepA : cA; const char* nB = has_next ? (const char*)g.Bt + (size_t)nxt.pn * tstepB : cB;
        for (int t = 0; t < nt; t += 2) {
            const bool last = (t == nt - 2);
            const char* a1 = cA + (size_t)(t + 1) * kstep;
            const char* a2 = last ? nA : cA + (size_t)(t + 2) * kstep; const char* b2 = last ? nB : cB + (size_t)(t + 2) * kstep;
            const char* a3 = a2 + kstep; const char* b3 = b2 + kstep;
            PG8_LDB(B0, 0, 0); PG8_LDB(B1, 0, 1); PG8_SCHED; PG8_LDA(At, 0, 0); PG8_STAGE(PG8_SA(1, 1), a1 + hstepA, voffA);
            PG8_WAIT_V(8); PG8_WAIT_L(0); PG8_BAR; PG8_MMA(0, 0, At, B0); PG8_MMA(0, 1, At, B1); PG8_BAR; PG8_SCHED;
            PG8_LDA(At, 0, 1); PG8_STAGE(PG8_SB(0, 0), b2, voffB); PG8_STAGE(PG8_SB(0, 1), b2 + hstepB, voffB); PG8_STAGE(PG8_SA(0, 0), a2, voffA);
            PG8_WAIT_V(8); PG8_WAIT_L(0); PG8_BAR; PG8_MMA(1, 0, At, B0); PG8_MMA(1, 1, At, B1); PG8_BAR; PG8_SCHED;
            PG8_LDB(B0, 1, 0); PG8_LDB(B1, 1, 1); PG8_SCHED; PG8_LDA(At, 1, 0); PG8_STAGE(PG8_SA(0, 1), a2 + hstepA, voffA);
            PG8_WAIT_V(8); PG8_WAIT_L(0); PG8_BAR; PG8_MMA(0, 0, At, B0); PG8_MMA(0, 1, At, B1); PG8_BAR; PG8_SCHED;
            PG8_LDA(At, 1, 1); PG8_STAGE(PG8_SB(1, 0), b3, voffB); PG8_STAGE(PG8_SB(1, 1), b3 + hstepB, voffB); PG8_STAGE(PG8_SA(1, 0), a3, voffA);
            PG8_WAIT_V(8); PG8_WAIT_L(0); PG8_BAR; PG8_MMA(1, 0, At, B0); PG8_MMA(1, 1, At, B1); PG8_BAR; PG8_SCHED;
        }
        if (wr == 0) PG8_BAR;
        E(acc, cur, wr, wc, fr, fq, rc);
        if (!has_next) break;
#pragma unroll
        for (int a = 0; a < 2; ++a)
#pragma unroll
            for (int b = 0; b < 2; ++b)
#pragma unroll
                for (int m = 0; m < 4; ++m)
#pragma unroll
                    for (int n = 0; n < 2; ++n) acc[a][b][m][n] = (f32x4){0.f, 0.f, 0.f, 0.f};
        cur = nxt; cA = nA; cB = nB; ++ui;
        if (wr == 1) PG8_BAR;
    }
    PG8_WAIT_V(0);
    PG8_BAR;
#undef PG8_SA
#undef PG8_SB
#undef PG8_STAGE
#undef PG8_LDA
#undef PG8_LDB
#undef PG8_MMA
#undef PG8_WAIT_V
#undef PG8_WAIT_L
#undef PG8_BAR
#undef PG8_SCHED
}

template <class Epi, class Sched, class GSel>
__device__ __forceinline__ void gemm_multi(LAS unsigned char* lds, const GSel GS, const Sched S, const Epi E, const int tid) {
    const int wid = __builtin_amdgcn_readfirstlane(tid >> 6), lane = tid & 63, wr = wid >> 2, wc = wid & 3, fr = lane & 15, fq = lane >> 4;
    const size_t kstep = (size_t)(BK * 2);
    const unsigned ldsw = (unsigned)wid * 1024u;
    const int aoff = lds_byte(wr * 64 + fr, fq * 8), boff = lds_byte(wc * 32 + fr, fq * 8);
#define PGM_VOFF(vA, vB, g) do { int R_, C_; stage_rc(tid * 16, R_, C_); const int Rb_ = (R_ & ~31) + perm32(R_ & 31); \
        vA = (unsigned)(R_ * (g).lda + C_) * 2u; vB = (unsigned)(Rb_ * (g).ldb + C_) * 2u; } while (0)
#define PG8_SA(b, h) (((b) * 2 + (h)) * HTB)
#define PG8_SB(b, h) ((4 + (b) * 2 + (h)) * HTB)
#define PG8_STAGE(bufoff, gbase, voff, q64) do { \
        __builtin_amdgcn_global_load_lds((const unsigned*)((const char*)(gbase) + (voff)), (LAS unsigned*)(lds + (bufoff) + ldsw), 16, 0, 0); \
        __builtin_amdgcn_global_load_lds((const unsigned*)((const char*)(gbase) + (q64) + (voff)), (LAS unsigned*)(lds + (bufoff) + ldsw + 8192), 16, 0, 0); } while (0)
#define PG8_LDA(dst, b, h) do { _Pragma("unroll") for (int m = 0; m < 4; ++m) _Pragma("unroll") for (int k = 0; k < 2; ++k) dst[m][k] = *(const LAS bf16x8*)(lds + PG8_SA(b, h) + aoff + m * 2048 + k * 1024); } while (0)
#define PG8_LDB(dst, b, h) do { _Pragma("unroll") for (int n = 0; n < 2; ++n) _Pragma("unroll") for (int k = 0; k < 2; ++k) dst[n][k] = *(const LAS bf16x8*)(lds + PG8_SB(b, h) + boff + n * 2048 + k * 1024); } while (0)
#define PG8_MMA(ai, bj, At, Bt) do { __builtin_amdgcn_s_setprio(1); _Pragma("unroll") for (int m = 0; m < 4; ++m) _Pragma("unroll") for (int n = 0; n < 2; ++n) _Pragma("unroll") for (int k = 0; k < 2; ++k) \
        acc[ai][bj][m][n] = __builtin_amdgcn_mfma_f32_16x16x32_bf16(Bt[n][k], At[m][k], acc[ai][bj][m][n], 0, 0, 0); __builtin_amdgcn_s_setprio(0); } while (0)
#define PG8_WAIT_V(n) asm volatile("s_waitcnt vmcnt(" #n ")" ::: "memory")
#define PG8_WAIT_L(n) asm volatile("s_waitcnt lgkmcnt(" #n ")" ::: "memory")
#define PG8_BAR __builtin_amdgcn_s_barrier()
#define PG8_SCHED __builtin_amdgcn_sched_barrier(0)
    Unit cur, nxt; int ui = 0;
    if (!S.next(0, cur)) return;
    RsCtx rc; rc.t = (const LAS float*)(lds + 132096); rc.p0 = -1; rc.p1 = -1; rc.ssq_x = nullptr;
    if constexpr (Epi::RS16 != 0) {
        rc.ssq_x = E.ssq_x; Unit uu;
        for (int i = 0; S.next(i, uu); ++i) { if (!Epi::rs_kind(uu.kind)) continue; const int key = uu.pm; if (key != rc.p0 && key != rc.p1) { if (rc.p0 < 0) rc.p0 = key; else if (rc.p1 < 0) rc.p1 = key; } }
        const int key = tid < 256 ? rc.p0 : rc.p1;
        if (key >= 0) ((LAS float*)(lds + 132096))[tid] = row_rs16(E.ssq_x, key * 256 + (tid & 255));
        asm volatile("s_waitcnt vmcnt(0) lgkmcnt(0)" ::: "memory"); __builtin_amdgcn_s_barrier(); asm volatile("" ::: "memory");
    }
    f32x4 acc[2][2][4][2];
#pragma unroll
    for (int a = 0; a < 2; ++a)
#pragma unroll
        for (int b = 0; b < 2; ++b)
#pragma unroll
            for (int m = 0; m < 4; ++m)
#pragma unroll
                for (int n = 0; n < 2; ++n) acc[a][b][m][n] = (f32x4){0.f, 0.f, 0.f, 0.f};
    bf16x8 At[4][2], B0[2][2], B1[2][2];
    Gemm gc = GS.get(cur.kind);
    int ntc = gc.K / BK; asm volatile("" : "+s"(ntc));
    unsigned vAc, vBc; PGM_VOFF(vAc, vBc, gc);
    size_t hAc = (size_t)HALF * gc.lda * 2, hBc = (size_t)HALF * gc.ldb * 2;
    const char* cA = (const char*)gc.A + (size_t)cur.pm * 2 * hAc; const char* cB = (const char*)gc.Bt + (size_t)cur.pn * 2 * hBc;
    PG8_STAGE(PG8_SB(0, 0), cB, vBc, hBc / 2); PG8_STAGE(PG8_SB(0, 1), cB + hBc, vBc, hBc / 2); PG8_STAGE(PG8_SA(0, 0), cA, vAc, hAc / 2); PG8_STAGE(PG8_SA(0, 1), cA + hAc, vAc, hAc / 2);
    if (wr == 1) PG8_BAR;
    PG8_WAIT_V(2); PG8_BAR;
    PG8_STAGE(PG8_SB(1, 0), cB + kstep, vBc, hBc / 2); PG8_STAGE(PG8_SA(1, 0), cA + kstep, vAc, hAc / 2); PG8_STAGE(PG8_SB(1, 1), cB + hBc + kstep, vBc, hBc / 2);
    PG8_WAIT_V(6); PG8_BAR;
    for (;;) {
        const bool has_next = S.next(ui + 1, nxt);
        if (!has_next) nxt = cur;
        const Gemm gn = GS.get(nxt.kind);
        unsigned vAn, vBn; PGM_VOFF(vAn, vBn, gn);
        const size_t hAn = (size_t)HALF * gn.lda * 2, hBn = (size_t)HALF * gn.ldb * 2;
        const char* nA = (const char*)gn.A + (size_t)nxt.pm * 2 * hAn; const char* nB = (const char*)gn.Bt + (size_t)nxt.pn * 2 * hBn;
        for (int t = 0; t < ntc; t += 2) {
            const bool last = (t == ntc - 2);
            const char* a1 = cA + (size_t)(t + 1) * kstep;
            const char* a2 = last ? nA : cA + (size_t)(t + 2) * kstep; const char* b2 = last ? nB : cB + (size_t)(t + 2) * kstep;
            const char* a3 = a2 + kstep; const char* b3 = b2 + kstep;
            const unsigned vA2 = last ? vAn : vAc, vB2 = last ? vBn : vBc;
            const size_t hA2 = last ? hAn : hAc, hB2 = last ? hBn : hBc;
            PG8_LDB(B0, 0, 0); PG8_LDB(B1, 0, 1); PG8_SCHED; PG8_LDA(At, 0, 0); PG8_STAGE(PG8_SA(1, 1), a1 + hAc, vAc, hAc / 2);
            PG8_WAIT_V(8); PG8_WAIT_L(0); PG8_BAR; PG8_MMA(0, 0, At, B0); PG8_MMA(0, 1, At, B1); PG8_BAR; PG8_SCHED;
            PG8_LDA(At, 0, 1); PG8_STAGE(PG8_SB(0, 0), b2, vB2, hB2 / 2); PG8_STAGE(PG8_SB(0, 1), b2 + hB2, vB2, hB2 / 2); PG8_STAGE(PG8_SA(0, 0), a2, vA2, hA2 / 2);
            PG8_WAIT_V(8); PG8_WAIT_L(0); PG8_BAR; PG8_MMA(1, 0, At, B0); PG8_MMA(1, 1, At, B1); PG8_BAR; PG8_SCHED;
            PG8_LDB(B0, 1, 0); PG8_LDB(B1, 1, 1); PG8_SCHED; PG8_LDA(At, 1, 0); PG8_STAGE(PG8_SA(0, 1), a2 + hA2, vA2, hA2 / 2);
            PG8_WAIT_V(8); PG8_WAIT_L(0); PG8_BAR; PG8_MMA(0, 0, At, B0); PG8_MMA(0, 1, At, B1); PG8_BAR; PG8_SCHED;
            PG8_LDA(At, 1, 1); PG8_STAGE(PG8_SB(1, 0), b3, vB2, hB2 / 2); PG8_STAGE(PG8_SB(1, 1), b3 + hB2, vB2, hB2 / 2); PG8_STAGE(PG8_SA(1, 0), a3, vA2, hA2 / 2);
            PG8_WAIT_V(8); PG8_WAIT_L(0); PG8_BAR; PG8_MMA(1, 0, At, B0); PG8_MMA(1, 1, At, B1); PG8_BAR; PG8_SCHED;
        }
        if (wr == 0) PG8_BAR;
        E(acc, cur, wr, wc, fr, fq, rc);
        if (!has_next) break;
#pragma unroll
        for (int a = 0; a < 2; ++a)
#pragma unroll
            for (int b = 0; b < 2; ++b)
#pragma unroll
                for (int m = 0; m < 4; ++m)
#pragma unroll
                    for (int n = 0; n < 2; ++n) acc[a][b][m][n] = (f32x4){0.f, 0.f, 0.f, 0.f};
        cur = nxt; cA = nA; cB = nB; vAc = vAn; vBc = vBn; hAc = hAn; hBc = hBn; ntc = gn.K / BK; asm volatile("" : "+s"(ntc)); ++ui;
        if (wr == 1) PG8_BAR;
    }
    PG8_WAIT_V(0);
    PG8_BAR;
#undef PGM_VOFF
#undef PG8_SA
#undef PG8_SB
#undef PG8_STAGE
#undef PG8_LDA
#undef PG8_LDB
#undef PG8_MMA
#undef PG8_WAIT_V
#undef PG8_WAIT_L
#undef PG8_BAR
#undef PG8_SCHED
}
}
using pg8::Unit;
typedef f32x4 Acc[2][2][4][2];


#define EPI_ROW(u, ai, wr, m, fr) ((u).pm * 256 + (ai) * 128 + (wr) * 64 + (m) * 16 + (fr))
struct EpiSwiGLU {
    static constexpr int RS16 = 1;
    bf16_t* O; const float* ssq_x;
    __device__ __forceinline__ void operator()(const Acc& acc, const Unit& u, int wr, int wc, int fr, int fq, const RsCtx& rc) const {
        const int col = u.pn * 128 + wc * 32 + 8 * fq;
#pragma unroll
        for (int ai = 0; ai < 2; ++ai)
#pragma unroll
            for (int m = 0; m < 4; ++m) { const int row = EPI_ROW(u, ai, wr, m, fr); const float rs = rc.get(u.pm, ai * 128 + wr * 64 + m * 16 + fr, row);
                f32x4 a0 = acc[ai][0][m][0] * rs, a1 = acc[ai][0][m][1] * rs; const f32x4 b0 = acc[ai][1][m][0] * rs, b1 = acc[ai][1][m][1] * rs;
#pragma unroll
                for (int e = 0; e < 4; ++e) { a0[e] = a0[e] * fast_sigmoid(a0[e]) * b0[e]; a1[e] = a1[e] * fast_sigmoid(a1[e]) * b1[e]; }
                *(u32x4*)(O + (size_t)row * FF + col) = pack8(a0, a1);
                if (m == 3) asm volatile("" ::: "memory"); }
    }
};
struct EpiResid {
    static constexpr int RS16 = 0;
    float* X; bf16_t* XB; float* ssq_x; float alpha;
    __device__ __forceinline__ void operator()(const Acc& acc, const Unit& u, int wr, int wc, int fr, int fq, const RsCtx& rc) const {
#pragma unroll
        for (int ai = 0; ai < 2; ++ai)
#pragma unroll
            for (int m = 0; m < 4; ++m) { const int row = EPI_ROW(u, ai, wr, m, fr); float s = 0.f;
#pragma unroll
                for (int bj = 0; bj < 2; ++bj) { const size_t off = (size_t)row * DM + u.pn * 256 + bj * 128 + wc * 32 + 8 * fq;
                    f32x4 x0, x1; unpack8(*(const u32x4*)(XB + off), x0, x1);
                    x0 = x0 + acc[ai][bj][m][0] * alpha; x1 = x1 + acc[ai][bj][m][1] * alpha;
                    *(u32x4*)(XB + off) = pack8(x0, x1);
#pragma unroll
                    for (int e = 0; e < 4; ++e) s += x0[e] * x0[e] + x1[e] * x1[e]; }
                s += __shfl_xor(s, 16); s += __shfl_xor(s, 32);
                if (fq == 0) ssq_x[(size_t)row * 16 + u.pn * 4 + wc] = s;
                if (m == 3) asm volatile("" ::: "memory"); }
    }
};
struct EpiWin {
    static constexpr int RS16 = 1;
    bf16_t *LAT, *CONVB, *CONVZ, *SWAQK; float *ssq_q, *ssq_kv; const float *TABM, *TABS; const float* ssq_x;
    __device__ __forceinline__ void operator()(const Acc& acc, const Unit& u, int wr, int wc, int fr, int fq, const RsCtx& rc) const {
        const int pn = u.pn, cw = wc * 32 + 8 * fq;
#pragma unroll
        for (int ai = 0; ai < 2; ++ai)
#pragma unroll
            for (int m = 0; m < 4; ++m) { const int row = EPI_ROW(u, ai, wr, m, fr);
                const float rs = rc.get(u.pm, ai * 128 + wr * 64 + m * 16 + fr, row);
                f32x4 a0 = acc[ai][0][m][0] * rs, a1 = acc[ai][0][m][1] * rs, b0 = acc[ai][1][m][0] * rs, b1 = acc[ai][1][m][1] * rs;
                if (pn == 0) {
                    float s = 0.f;
#pragma unroll
                    for (int e = 0; e < 4; ++e) s += a0[e] * a0[e] + a1[e] * a1[e] + b0[e] * b0[e] + b1[e] * b1[e];
                    s += __shfl_xor(s, 16); s += __shfl_xor(s, 32);
                    if (fq == 0) ssq_q[row * 4 + wc] = s;
                    *(u32x4*)(LAT + (size_t)row * 512 + cw) = pack8(a0, a1); *(u32x4*)(LAT + (size_t)row * 512 + 128 + cw) = pack8(b0, b1);
                } else if (pn == 1) {
                    float s = 0.f;
#pragma unroll
                    for (int e = 0; e < 4; ++e) s += a0[e] * a0[e] + a1[e] * a1[e];
                    s += __shfl_xor(s, 16); s += __shfl_xor(s, 32);
                    if (fq == 0) ssq_kv[row * 4 + wc] = s;
                    *(u32x4*)(LAT + (size_t)row * 512 + 256 + cw) = pack8(a0, a1);
                    if (wc == 0) { rope8(b0, b1, TABM + ((size_t)tok_pos(row) * 16 + 4 * fq) * 2); *(u32x4*)(LAT + (size_t)row * 512 + 384 + cw) = pack8(b0, b1); }
                } else if (pn < 4) {
                    bf16_t* p = CONVB + (size_t)row * 512 + (pn - 2) * 256 + cw;
                    *(u32x4*)p = pack8(a0, a1); *(u32x4*)(p + 128) = pack8(b0, b1);
                } else if (pn < 8) {
                    *(u32x4*)(CONVZ + (size_t)row * 512 + (pn - 4) * 128 + cw) = pack8(a0 * b0, a1 * b1);
                } else if (pn < 10) {
                    const int c = (pn - 8) * 256 + cw; const float* tb = TABS + (size_t)tok_pos(row) * 64;
                    rope8(a0, a1, tb + (c & 63)); rope8(b0, b1, tb + ((c + 128) & 63));
                    const float sc = 0.125f * LOG2E;
                    *(u32x4*)(SWAQK + (size_t)row * 768 + c) = pack8(a0 * sc, a1 * sc); *(u32x4*)(SWAQK + (size_t)row * 768 + c + 128) = pack8(b0 * sc, b1 * sc);
                } else {
                    rope8(a0, a1, TABS + (size_t)tok_pos(row) * 64 + (cw & 63));
                    *(u32x4*)(SWAQK + (size_t)row * 768 + 512 + cw) = pack8(a0, a1);
                }
                if (m == 3) asm volatile("" ::: "memory");
            }
    }
};
struct EpiQ {
    static constexpr int RS16 = 0;
    bf16_t* Q; const float* ssq_q; const float* TABM;
    __device__ __forceinline__ void operator()(const Acc& acc, const Unit& u, int wr, int wc, int fr, int fq, const RsCtx& rc) const {
        const float C2 = 0.10206207261596577f * LOG2E;
#pragma unroll
        for (int ai = 0; ai < 2; ++ai)
#pragma unroll
            for (int m = 0; m < 4; ++m) { const int row = EPI_ROW(u, ai, wr, m, fr);
                const f32x4 sp = *(const f32x4*)(ssq_q + row * 4); const float rs = rsqrtf(((sp[0] + sp[1]) + (sp[2] + sp[3])) * (1.0f / 256.0f) + EPS) * C2; const float* tb = TABM + (size_t)tok_pos(row) * 32;
#pragma unroll
                for (int bj = 0; bj < 2; ++bj) { const int c = u.pn * 256 + bj * 128 + wc * 32 + 8 * fq; const int d = c % 96;
                    f32x4 v0 = acc[ai][bj][m][0] * rs, v1 = acc[ai][bj][m][1] * rs;
                    if (d >= 64) rope8(v0, v1, tb + (d - 64));
                    *(u32x4*)(Q + (size_t)row * 768 + c) = pack8(v0, v1); }
                if (m == 3) asm volatile("" ::: "memory"); }
    }
};
struct EpiRowScale {
    static constexpr int RS16 = 0;
    bf16_t* O; const float* ssq;
    __device__ __forceinline__ void operator()(const Acc& acc, const Unit& u, int wr, int wc, int fr, int fq, const RsCtx& rc) const {
#pragma unroll
        for (int ai = 0; ai < 2; ++ai)
#pragma unroll
            for (int m = 0; m < 4; ++m) { const int row = EPI_ROW(u, ai, wr, m, fr); const f32x4 sp = *(const f32x4*)(ssq + row * 4); const float rs = rsqrtf(((sp[0] + sp[1]) + (sp[2] + sp[3])) * (1.0f / 128.0f) + EPS);
#pragma unroll
                for (int bj = 0; bj < 2; ++bj) *(u32x4*)(O + (size_t)row * 512 + u.pn * 256 + bj * 128 + wc * 32 + 8 * fq) = pack8(acc[ai][bj][m][0] * rs, acc[ai][bj][m][1] * rs);
                if (m == 3) asm volatile("" ::: "memory"); }
    }
};
struct EpiColScaleT {
    static constexpr int RS16 = 0;
    bf16_t* O; const float* ssq; int nrows; bool x16;
    __device__ __forceinline__ void operator()(const Acc& acc, const Unit& u, int wr, int wc, int fr, int fq, const RsCtx& rc) const {
#pragma unroll
        for (int bj = 0; bj < 2; ++bj) { const int c = u.pn * 256 + bj * 128 + wc * 32 + 8 * fq;
            f32x4 r0 = (f32x4){1.f, 1.f, 1.f, 1.f}, r1 = r0;
            if (x16) {
#pragma unroll
                for (int e = 0; e < 4; ++e) { r0[e] = row_rs16(ssq, c + e); r1[e] = row_rs16(ssq, c + 4 + e); }
            } else {
#pragma unroll
                for (int e = 0; e < 4; ++e) { const f32x4 sa = *(const f32x4*)(ssq + (c + e) * 4), sb = *(const f32x4*)(ssq + (c + 4 + e) * 4);
                    r0[e] = rsqrtf(((sa[0] + sa[1]) + (sa[2] + sa[3])) * (1.0f / 128.0f) + EPS); r1[e] = rsqrtf(((sb[0] + sb[1]) + (sb[2] + sb[3])) * (1.0f / 128.0f) + EPS); } }
#pragma unroll
            for (int ai = 0; ai < 2; ++ai)
#pragma unroll
                for (int m = 0; m < 4; ++m) { const int row = EPI_ROW(u, ai, wr, m, fr);
                    if (row < nrows) *(u32x4*)(O + (size_t)row * T + c) = pack8(acc[ai][bj][m][0] * r0, acc[ai][bj][m][1] * r1); } }
    }
};
struct EpiGate {
    static constexpr int RS16 = 1;
    unsigned char* G; const float* ssq_x;
    __device__ __forceinline__ void operator()(const Acc& acc, const Unit& u, int wr, int wc, int fr, int fq, const RsCtx& rc) const {
#pragma unroll
        for (int ai = 0; ai < 2; ++ai)
#pragma unroll
            for (int m = 0; m < 4; ++m) { const int row = EPI_ROW(u, ai, wr, m, fr); const float rs = rc.get(u.pm, ai * 128 + wr * 64 + m * 16 + fr, row);
#pragma unroll
                for (int bj = 0; bj < 2; ++bj) { f32x4 v0 = acc[ai][bj][m][0] * rs, v1 = acc[ai][bj][m][1] * rs;
#pragma unroll
                    for (int e = 0; e < 4; ++e) { v0[e] = __builtin_rintf(fast_sigmoid(v0[e]) * 255.0f); v1[e] = __builtin_rintf(fast_sigmoid(v1[e]) * 255.0f); }
                    u32x2 w; w.x = 0u; w.y = 0u;
                    w.x = __builtin_amdgcn_cvt_pk_u8_f32(v0[0], 0, w.x); w.x = __builtin_amdgcn_cvt_pk_u8_f32(v0[1], 1, w.x); w.x = __builtin_amdgcn_cvt_pk_u8_f32(v0[2], 2, w.x); w.x = __builtin_amdgcn_cvt_pk_u8_f32(v0[3], 3, w.x);
                    w.y = __builtin_amdgcn_cvt_pk_u8_f32(v1[0], 0, w.y); w.y = __builtin_amdgcn_cvt_pk_u8_f32(v1[1], 1, w.y); w.y = __builtin_amdgcn_cvt_pk_u8_f32(v1[2], 2, w.y); w.y = __builtin_amdgcn_cvt_pk_u8_f32(v1[3], 3, w.y);
                    *(u32x2*)(G + (size_t)row * DM + u.pn * 256 + bj * 128 + wc * 32 + 8 * fq) = w; } }
    }
};
struct EpiMerge {
    static constexpr int RS16 = 0;
    const unsigned char* G; bf16_t* Mg; bool first;
    __device__ __forceinline__ void operator()(const Acc& acc, const Unit& u, int wr, int wc, int fr, int fq, const RsCtx& rc) const {
#pragma unroll
        for (int ai = 0; ai < 2; ++ai)
#pragma unroll
            for (int m = 0; m < 4; ++m) { const int row = EPI_ROW(u, ai, wr, m, fr);
#pragma unroll
                for (int bj = 0; bj < 2; ++bj) { const size_t off = (size_t)row * DM + u.pn * 256 + bj * 128 + wc * 32 + 8 * fq;
                    const u32x2 gw = *(const u32x2*)(G + off); const float k255 = 1.0f / 255.0f;
                    const f32x4 g0 = (f32x4){(float)(gw.x & 0xffu), (float)((gw.x >> 8) & 0xffu), (float)((gw.x >> 16) & 0xffu), (float)(gw.x >> 24)} * k255;
                    const f32x4 g1 = (f32x4){(float)(gw.y & 0xffu), (float)((gw.y >> 8) & 0xffu), (float)((gw.y >> 16) & 0xffu), (float)(gw.y >> 24)} * k255;
                    f32x4 v0 = g0 * acc[ai][bj][m][0], v1 = g1 * acc[ai][bj][m][1];
                    if (!first) { f32x4 o0, o1; unpack8(*(const u32x4*)(Mg + off), o0, o1); v0 = v0 + o0; v1 = v1 + o1; }
                    *(u32x4*)(Mg + off) = pack8(v0, v1); }
                if (m == 3) asm volatile("" ::: "memory"); }
    }
};

struct UnitMajor6 {
    pg8::StaticOrder S;
    __device__ __forceinline__ bool next(int i, Unit& u) const { const int j = i / 6; if (!S.next(j, u)) return false; u.kind = i - 6 * j; return true; }
};
struct GSelMerge { unsigned char* ws; unsigned char* Wb;
    __device__ __forceinline__ pg8::Gemm get(int kind) const { const int b = kind >> 1; pg8::Gemm g; g.M = T; g.N = DM;
        if (kind & 1) { const size_t oa = b == 0 ? WS_CONVB : (b == 1 ? WS_CB : WS_CONVZ); g.A = (const bf16_t*)(ws + oa); g.Bt = (const bf16_t*)(Wb + O_WAO + (size_t)b * 1048576); g.K = 512; g.lda = 512; g.ldb = 512; }
        else { g.A = (const bf16_t*)(ws + WS_HB); g.Bt = (const bf16_t*)(Wb + O_WG) + (size_t)b * 1024 * 1024; g.K = DM; g.lda = DM; g.ldb = DM; }
        return g; } };
struct EpiGateMerge {
    static constexpr int RS16 = 1;
    __device__ static __forceinline__ bool rs_kind(int kind) { return (kind & 1) == 0; }
    unsigned char* G; bf16_t* Mg; const float* ssq_x;
    __device__ __forceinline__ void operator()(const Acc& acc, const Unit& u, int wr, int wc, int fr, int fq, const RsCtx& rc) const {
        int fr2 = fr, fq2 = fq; asm volatile("" : "+v"(fr2), "+v"(fq2));
        if (u.kind & 1) { EpiMerge m; m.G = G; m.Mg = Mg; m.first = (u.kind == 1); m(acc, u, wr, wc, fr2, fq2, rc); }
        else { EpiGate g; g.G = G; g.ssq_x = ssq_x; g(acc, u, wr, wc, fr2, fq2, rc); }
    }
};

__device__ __forceinline__ bf16_t* wdst(int kind, int n, unsigned char* Wb) {
    switch (kind) {
    case 0: case 2: { const int up = n >= FF, j = up ? n - FF : n; const int row = 256 * (j >> 7) + (j & 127) + (up ? 128 : 0); return (bf16_t*)(Wb + (kind == 0 ? O_GU1 : O_GU2)) + (size_t)row * 1024; }
    case 1: case 3: return (bf16_t*)(Wb + (kind == 1 ? O_DN1 : O_DN2)) + (size_t)n * FF;
    case 4: {
        bf16_t* WIN = (bf16_t*)(Wb + O_WIN); int row;
        if (n < 384) row = n;
        else if (n < 416) { const int c = n - 384; row = 384 + 2 * (c & 15) + (c >> 4); }
        else if (n < 928) row = 512 + (n - 416);
        else if (n < 1440) { const int c = n - 928; row = 1024 + 256 * (c >> 7) + (c & 127); }
        else if (n < 1952) { const int c = n - 1440; row = 1024 + 256 * (c >> 7) + 128 + (c & 127); }
        else if (n < 2464) { const int c = n - 1952, hd = c >> 6, d = c & 63; row = 2048 + hd * 64 + 2 * (d & 31) + (d >> 5); }
        else if (n < 2592) { const int c = n - 2464, hd = c >> 6, d = c & 63; row = 2560 + hd * 64 + 2 * (d & 31) + (d >> 5); }
        else if (n < 2720) return (bf16_t*)(Wb + O_WSV) + (size_t)(n - 2592) * 1024;
        else return (bf16_t*)(Wb + O_WG) + (size_t)(n - 2720) * 1024;
        return WIN + (size_t)row * 1024; }
    case 5: { const int hd = n / 96, d = n - hd * 96; int row = n; if (d >= 64) { const int c = d - 64; row = hd * 96 + 64 + 2 * (c & 15) + (c >> 4); } return (bf16_t*)(Wb + O_WUQ) + (size_t)row * 256; }
    case 6: { const int hd = n >> 7, d = n & 127; return d < 64 ? (bf16_t*)(Wb + O_WUK) + (size_t)(hd * 64 + d) * 128 : (bf16_t*)(Wb + O_WUV) + (size_t)(hd * 64 + d - 64) * 128; }
    case 7: return (bf16_t*)(Wb + O_WAO) + (size_t)n * 512;
    case 8: return (bf16_t*)(Wb + O_WBO) + (size_t)n * 512;
    case 9: return (bf16_t*)(Wb + O_WCO) + (size_t)n * 512;
    default: return (bf16_t*)(Wb + O_WO) + (size_t)n * 1024;
    }
}
__device__ __forceinline__ void conv_item(const float* W, int K, int N, int kind, int item, const float* gain, unsigned char* Wb, float* scr, int lane) {
    const int nblk = N / 32, kb = item / nblk, nb = item - kb * nblk, k0 = 64 * kb, n0 = 32 * nb;
    float wv_[32];
#pragma unroll
    for (int i = 0; i < 32; ++i) wv_[i] = W[(size_t)(k0 + 2 * i + (lane >> 5)) * N + n0 + (lane & 31)];
#pragma unroll
    for (int i = 0; i < 32; ++i) scr[(2 * i + (lane >> 5)) * 33 + (lane & 31)] = wv_[i];
    __builtin_amdgcn_s_waitcnt(0); asm volatile("" ::: "memory");
    const int c = lane & 7; float gg[8];
#pragma unroll
    for (int e = 0; e < 8; ++e) gg[e] = gain ? gain[k0 + 8 * c + e] : 1.0f;
#pragma unroll
    for (int j = 0; j < 4; ++j) { const int n = (lane >> 3) + 8 * j; const float* s = scr + (8 * c) * 33 + n;
        u32x4 o; o.x = pk2(s[0] * gg[0], s[33] * gg[1]); o.y = pk2(s[2 * 33] * gg[2], s[3 * 33] * gg[3]); o.z = pk2(s[4 * 33] * gg[4], s[5 * 33] * gg[5]); o.w = pk2(s[6 * 33] * gg[6], s[7 * 33] * gg[7]);
        *(u32x4*)(wdst(kind, n0 + n, Wb) + k0 + 8 * c) = o; }
    __builtin_amdgcn_s_waitcnt(0); asm volatile("" ::: "memory");
}

constexpr int AT_KB = 12 * 1024, AT_BUF = AT_KB + 8 * 1024;
#define AT_SB() __builtin_amdgcn_sched_barrier(0)
template <bool SWA>
__device__ __forceinline__ void attn_unit(unsigned char* lds, LAS unsigned char* ldsl, const bf16_t* Qrow, const bf16_t* Kp, int ldk, const bf16_t* Kr, const bf16_t* Vt,
                                          int ntiles, float m_init, float l_init, int qrel, bf16_t* Owave, const int tid) {
    constexpr int ND = SWA ? 4 : 6;
    constexpr float THR = 6.0f;
    const int lane = tid & 63, l32 = lane & 31, hi = lane >> 5; const int wv = __builtin_amdgcn_readfirstlane(tid >> 6);
    bf16x8 qf[ND];
#pragma unroll
    for (int d0 = 0; d0 < ND; ++d0) qf[d0] = *(const bf16x8*)(Qrow + 16 * d0 + 8 * hi);
    const int pkey = (lane & ~12) | ((lane & 4) << 1) | ((lane & 8) >> 1);
    const int koff = pkey * ldk + 8 * wv, voff = lane * T + 8 * wv, roff = pkey * 512 + 8 * (wv & 3);
    const bool do_r = (!SWA) && wv < 4;
    const int kfo = hi * 1024 + l32 * 16, vfo = AT_KB + hi * 1024 + l32 * 16;
#define AT_GLOAD(tt, boff) do { \
        __builtin_amdgcn_global_load_lds((const unsigned*)((Kp + (size_t)(tt) * 64 * ldk) + koff), (LAS unsigned*)(ldsl + (boff) + wv * 1024), 16, 0, 0); \
        __builtin_amdgcn_global_load_lds((const unsigned*)((Vt + (tt) * 64) + voff), (LAS unsigned*)(ldsl + (boff) + AT_KB + wv * 1024), 16, 0, 0); \
        if (do_r) __builtin_amdgcn_global_load_lds((const unsigned*)((Kr + (size_t)(tt) * 64 * 512) + roff), (LAS unsigned*)(ldsl + (boff) + 8192 + wv * 1024), 16, 0, 0); } while (0)
    AT_GLOAD(0, 0); AT_GLOAD(1, AT_BUF);
    asm volatile("s_waitcnt vmcnt(0)" ::: "memory");
    __syncthreads();
    f32x16 o0, o1, negm;
    float mref = SWA ? m_init : 0.f, lrun = l_init;
#pragma unroll
    for (int r = 0; r < 16; ++r) { o0[r] = 0.f; o1[r] = 0.f; negm[r] = -mref; }
    f32x16 sA0, sA1, sB0, sB1;
#define AT_MASK(S0, S1, tt) do { if (SWA) { const int kb_ = (tt) * 64 + 8 * hi - qrel; _Pragma("unroll") for (int r = 0; r < 16; ++r) { const int d_ = kb_ + 16 * (r >> 3) + (r & 7); \
        if (d_ < -128 || d_ > 128) S0[r] = -1e30f; if (d_ + 32 < -128 || d_ + 32 > 128) S1[r] = -1e30f; } } } while (0)
    {
        const unsigned char* Bn = lds;
        sA0 = __builtin_amdgcn_mfma_f32_32x32x16_bf16(*(const bf16x8*)(Bn + kfo), qf[0], negm, 0, 0, 0);
        sA1 = __builtin_amdgcn_mfma_f32_32x32x16_bf16(*(const bf16x8*)(Bn + kfo + 512), qf[0], negm, 0, 0, 0);
#pragma unroll
        for (int d0 = 1; d0 < ND; ++d0) { sA0 = __builtin_amdgcn_mfma_f32_32x32x16_bf16(*(const bf16x8*)(Bn + kfo + 2048 * d0), qf[d0], sA0, 0, 0, 0);
            sA1 = __builtin_amdgcn_mfma_f32_32x32x16_bf16(*(const bf16x8*)(Bn + kfo + 512 + 2048 * d0), qf[d0], sA1, 0, 0, 0); }
        AT_MASK(sA0, sA1, 0);
    }
    int bt = 0, bn = AT_BUF, bw = 2 * AT_BUF;
#define AT_STEP(tt, SC0, SC1, SN0, SN1, FULL) do { \
        const bool more2_ = ((tt) + 2) < ntiles; \
        if (more2_) AT_GLOAD((tt) + 2, bw); \
        float mx_; \
        { float ma = __builtin_fmaxf(__builtin_fmaxf(SC0[0], SC0[1]), SC1[0]), mb = __builtin_fmaxf(__builtin_fmaxf(SC0[2], SC0[3]), SC1[1]); \
          ma = __builtin_fmaxf(__builtin_fmaxf(ma, SC1[2]), SC1[3]); \
          _Pragma("unroll") for (int r = 4; r < 16; r += 4) { ma = __builtin_fmaxf(__builtin_fmaxf(ma, SC0[r]), SC0[r + 1]); mb = __builtin_fmaxf(__builtin_fmaxf(mb, SC0[r + 2]), SC0[r + 3]); \
              ma = __builtin_fmaxf(__builtin_fmaxf(ma, SC1[r]), SC1[r + 1]); mb = __builtin_fmaxf(__builtin_fmaxf(mb, SC1[r + 2]), SC1[r + 3]); } \
          mx_ = __builtin_fmaxf(ma, mb); \
          auto rr = __builtin_amdgcn_permlane32_swap(__float_as_uint(mx_), __float_as_uint(mx_), false, false); mx_ = __builtin_fmaxf(__uint_as_float(rr[0]), __uint_as_float(rr[1])); } \
        const bool reset_ = (!SWA) && (tt) == 0; \
        if (__any(reset_ || mx_ > THR)) { \
            const float dl = reset_ ? mx_ : __builtin_fmaxf(mx_, 0.f); \
            mref += dl; const float alpha = __builtin_amdgcn_exp2f(-dl); lrun *= alpha; \
            _Pragma("unroll") for (int r = 0; r < 16; ++r) { SC0[r] -= dl; SC1[r] -= dl; o0[r] *= alpha; o1[r] *= alpha; negm[r] = -mref; } \
        } \
        AT_SB(); \
        const unsigned char* Bn_ = lds + bn; const unsigned char* Bt_ = lds + bt; \
        if (FULL) { \
            SN0 = __builtin_amdgcn_mfma_f32_32x32x16_bf16(*(const bf16x8*)(Bn_ + kfo), qf[0], negm, 0, 0, 0); \
            SN1 = __builtin_amdgcn_mfma_f32_32x32x16_bf16(*(const bf16x8*)(Bn_ + kfo + 512), qf[0], negm, 0, 0, 0); \
            _Pragma("unroll") for (int d0 = 1; d0 < ND; ++d0) { SN0 = __builtin_amdgcn_mfma_f32_32x32x16_bf16(*(const bf16x8*)(Bn_ + kfo + 2048 * d0), qf[d0], SN0, 0, 0, 0); \
                SN1 = __builtin_amdgcn_mfma_f32_32x32x16_bf16(*(const bf16x8*)(Bn_ + kfo + 512 + 2048 * d0), qf[d0], SN1, 0, 0, 0); } \
        } \
        float ls_ = 0.f; \
        _Pragma("unroll") for (int r = 0; r < 16; ++r) { SC0[r] = __builtin_amdgcn_exp2f(SC0[r]); SC1[r] = __builtin_amdgcn_exp2f(SC1[r]); ls_ += SC0[r] + SC1[r]; } \
        lrun += ls_; \
        bf16x8 pf_[4]; \
        { u32x4 w; \
          w.x = pk2(SC0[0], SC0[1]); w.y = pk2(SC0[2], SC0[3]); w.z = pk2(SC0[4], SC0[5]); w.w = pk2(SC0[6], SC0[7]); pf_[0] = __builtin_bit_cast(bf16x8, w); \
          w.x = pk2(SC0[8], SC0[9]); w.y = pk2(SC0[10], SC0[11]); w.z = pk2(SC0[12], SC0[13]); w.w = pk2(SC0[14], SC0[15]); pf_[1] = __builtin_bit_cast(bf16x8, w); \
          w.x = pk2(SC1[0], SC1[1]); w.y = pk2(SC1[2], SC1[3]); w.z = pk2(SC1[4], SC1[5]); w.w = pk2(SC1[6], SC1[7]); pf_[2] = __builtin_bit_cast(bf16x8, w); \
          w.x = pk2(SC1[8], SC1[9]); w.y = pk2(SC1[10], SC1[11]); w.z = pk2(SC1[12], SC1[13]); w.w = pk2(SC1[14], SC1[15]); pf_[3] = __builtin_bit_cast(bf16x8, w); } \
        _Pragma("unroll") for (int g = 0; g < 4; ++g) { o0 = __builtin_amdgcn_mfma_f32_32x32x16_bf16(*(const bf16x8*)(Bt_ + vfo + 2048 * g), pf_[g], o0, 0, 0, 0); \
            o1 = __builtin_amdgcn_mfma_f32_32x32x16_bf16(*(const bf16x8*)(Bt_ + vfo + 512 + 2048 * g), pf_[g], o1, 0, 0, 0); } \
        if (FULL) { __builtin_amdgcn_sched_group_barrier(0x100, 4, 0); \
            _Pragma("unroll") for (int i_ = 0; i_ < 2 * ND; ++i_) { __builtin_amdgcn_sched_group_barrier(0x008, 1, 0); __builtin_amdgcn_sched_group_barrier(0x100, 2, 0); __builtin_amdgcn_sched_group_barrier(0x402, SWA ? 6 : 4, 0); } \
            _Pragma("unroll") for (int i_ = 0; i_ < 8; ++i_) { __builtin_amdgcn_sched_group_barrier(0x008, 1, 0); __builtin_amdgcn_sched_group_barrier(0x402, 6, 0); } } \
        AT_SB(); \
        if (FULL) AT_MASK(SN0, SN1, (tt) + 1); \
        asm volatile("s_waitcnt vmcnt(0)" ::: "memory"); \
        __syncthreads(); \
        { const int t_ = bt; bt = bn; bn = bw; bw = t_; } \
    } while (0)
    int t = 0;
    if (wv >= 4) __builtin_amdgcn_s_setprio(1);
    for (; t < ntiles - 2; t += 2) { AT_STEP(t, sA0, sA1, sB0, sB1, true); AT_STEP(t + 1, sB0, sB1, sA0, sA1, true); }
    AT_STEP(t, sA0, sA1, sB0, sB1, true);
    AT_STEP(t + 1, sB0, sB1, sA0, sA1, false);
    if (wv >= 4) __builtin_amdgcn_s_setprio(0);
#undef AT_STEP
#undef AT_MASK
#undef AT_GLOAD
    { auto rr = __builtin_amdgcn_permlane32_swap(__float_as_uint(lrun), __float_as_uint(lrun), false, false); lrun = __uint_as_float(rr[0]) + __uint_as_float(rr[1]); }
    const float inv = 1.0f / lrun;
    int tl2 = tid; asm volatile("" : "+v"(tl2));
    bf16_t* Orow = Owave + (size_t)(tl2 & 31) * 512;
#pragma unroll
    for (int rq = 0; rq < 4; ++rq) {
        u32x2 w; w.x = pk2(o0[4 * rq] * inv, o0[4 * rq + 1] * inv); w.y = pk2(o0[4 * rq + 2] * inv, o0[4 * rq + 3] * inv);
        *(u32x2*)(Orow + 8 * rq + 4 * (tl2 & 32 ? 1 : 0)) = w;
        w.x = pk2(o1[4 * rq] * inv, o1[4 * rq + 1] * inv); w.y = pk2(o1[4 * rq + 2] * inv, o1[4 * rq + 3] * inv);
        *(u32x2*)(Orow + 32 + 8 * rq + 4 * (tl2 & 32 ? 1 : 0)) = w;
    }
}

#define XB_TMO      128
#define XB_XCNT(j)  (256  + 64 * (j))
#define XB_XSUB(j)  (1280 + 64 * (j))
#define XB_XGEN(j)  (2304 + 64 * (j))
#define XB_TOP      3328
#define XB_TOPGEN   3392
#define XCD_BAR_WORDS 3456
#define XB_SPIN_CAP (1u << 22)
__device__ __forceinline__ unsigned xb_ld(unsigned* p)              { return __hip_atomic_load(p, __ATOMIC_RELAXED, __HIP_MEMORY_SCOPE_AGENT); }
__device__ __forceinline__ unsigned xb_add(unsigned* p, unsigned v) { return __hip_atomic_fetch_add(p, v, __ATOMIC_RELAXED, __HIP_MEMORY_SCOPE_AGENT); }
__device__ __forceinline__ unsigned xb_xcc_id() { return (unsigned)__builtin_amdgcn_s_getreg((3 << 11) | 20) & 0xFu; }
#define XB_SPIN(cond, bar) do { unsigned _sp = 0; while (cond) { __builtin_amdgcn_s_sleep(1); \
    if ((++_sp & 255u) == 0u) { if (xb_ld(&(bar)[XB_TMO])) break; if (_sp > XB_SPIN_CAP) { atomicAdd(&(bar)[XB_TMO], 1u); break; } } } } while (0)
struct XcdBarrier { unsigned* bar; unsigned x; volatile LAS unsigned* st; };
__device__ __forceinline__ XcdBarrier xcd_barrier_post(unsigned* bar, volatile LAS unsigned* st) {
    XcdBarrier b; b.bar = bar; b.x = xb_xcc_id(); b.st = st;
    if (threadIdx.x == 0) (void)xb_add(&bar[XB_XCNT(b.x)], 1u);
    return b;
}
__device__ __forceinline__ void xcd_barrier_complete(unsigned* bar, unsigned x, unsigned& nloc, unsigned& nx) {
    const unsigned G = gridDim.x * gridDim.y * gridDim.z;
    unsigned sum, cnt, mine, sp = 0u;
    for (;;) {
        sum = 0u; cnt = 0u; mine = 0u;
#pragma unroll
        for (unsigned j = 0; j < 16; ++j) { const unsigned c = xb_ld(&bar[XB_XCNT(j)]); sum += c; cnt += (c > 0u) ? 1u : 0u; mine = (j == x) ? c : mine; }
        if (sum == G) break;
        __builtin_amdgcn_s_sleep(1);
        if ((++sp & 255u) == 0u) { if (xb_ld(&bar[XB_TMO])) break; if (sp > XB_SPIN_CAP) { atomicAdd(&bar[XB_TMO], 1u); break; } }
    }
    nloc = mine > 0u ? mine : 1u; nx = cnt > 0u ? cnt : 1u;
}
__device__ __forceinline__ void xcd_barrier(const XcdBarrier& b) {
    asm volatile("s_waitcnt vmcnt(0)" ::: "memory");
    __syncthreads();
    if (threadIdx.x == 0) {
        unsigned* bar = b.bar;
        __builtin_amdgcn_s_waitcnt(0);
        unsigned nloc = b.st[0], nx = b.st[1];
        if (nloc == 0u) { xcd_barrier_complete(bar, b.x, nloc, nx); b.st[0] = nloc; b.st[1] = nx; }
        const unsigned old = xb_add(&bar[XB_XSUB(b.x)], 1u);
        const unsigned gen = old / nloc;
        if (old + 1u == (gen + 1u) * nloc) {
            __builtin_amdgcn_fence(__ATOMIC_RELEASE, "agent");
            asm volatile("s_waitcnt vmcnt(0)" ::: "memory");
            const unsigned og = xb_add(&bar[XB_TOP], 1u);
            const unsigned tg = og / nx;
            if (og + 1u == (tg + 1u) * nx) xb_add(&bar[XB_TOPGEN], 1u);
            else XB_SPIN(xb_ld(&bar[XB_TOPGEN]) == tg, bar);
            __builtin_amdgcn_fence(__ATOMIC_ACQUIRE, "agent");
            xb_add(&bar[XB_XGEN(b.x)], 1u);
            asm volatile("s_waitcnt vmcnt(0)" ::: "memory");
        } else {
            XB_SPIN(xb_ld(&bar[XB_XGEN(b.x)]) == gen, bar);
            __builtin_amdgcn_fence(__ATOMIC_ACQUIRE, "agent");
            asm volatile("s_waitcnt vmcnt(0)" ::: "memory");
        }
    }
    __syncthreads();
}

struct Args { const float* in[21]; float* out; unsigned char* ws; int ph_lo, ph_hi; };

__global__ void __launch_bounds__(512, 2) mk_fwd(Args a) {
    extern __shared__ __attribute__((aligned(16))) unsigned char lds[];
    cg::grid_group grid = cg::this_grid();
    volatile LAS unsigned* bst = (volatile LAS unsigned*)((LAS unsigned char*)lds + 131072 + 256);
    if (threadIdx.x < 2) bst[threadIdx.x] = 0u;
    __syncthreads();
    XcdBarrier xbar; xbar.bar = (unsigned*)(a.ws + WS_BAR); xbar.x = 0; xbar.st = bst;
    if (a.ph_hi - a.ph_lo > 1) xbar = xcd_barrier_post((unsigned*)(a.ws + WS_BAR), bst);
    bool dup_done = false;
#pragma nounroll
    for (int ph = a.ph_lo; ph < a.ph_hi; ++ph) {
            typedef const __attribute__((address_space(4))) Args* KArgs;
            KArgs ap = (KArgs)__builtin_amdgcn_kernarg_segment_ptr(); asm volatile("" : "+s"(ap));
            int tid = threadIdx.x; asm volatile("" : "+v"(tid));
            const int wave = __builtin_amdgcn_readfirstlane(tid >> 6);
#define LOCAL_LANE int tl_ = tid; asm volatile("" : "+v"(tl_)); const int lane = tl_ & 63
        const int G = gridDim.x, bx = blockIdx.x;
        const int vcu = (G % 8 == 0) ? (bx % 8) * (G / 8) + bx / 8 : bx;
        const int gw = vcu * 8 + wave, NGW = G * 8;
        unsigned char* ws = ap->ws; asm volatile("" : "+s"(ws));
        float* X = ap->out; asm volatile("" : "+s"(X));
        float* ssq_q = (float*)(ws + WS_SSQQ); float* ssq_kv = (float*)(ws + WS_SSQKV); float* ssq_x = (float*)(ws + WS_SSQX);
        float* TABM = (float*)(ws + WS_TABM); float* TABS = (float*)(ws + WS_TABS);
        unsigned char* Wb = ws + WS_W;
        bf16_t* HB = (bf16_t*)(ws + WS_HB); bf16_t* ACT = (bf16_t*)(ws + WS_ACT); bf16_t* LAT = (bf16_t*)(ws + WS_LAT);
        bf16_t* CONVB = (bf16_t*)(ws + WS_CONVB); bf16_t* CONVZ = (bf16_t*)(ws + WS_CONVZ); bf16_t* SWAQK = (bf16_t*)(ws + WS_SWAQK);
        bf16_t* SWAVT = (bf16_t*)(ws + WS_SWAVT); bf16_t* CB = (bf16_t*)(ws + WS_CB); bf16_t* Q = (bf16_t*)(ws + WS_Q);
        bf16_t* KNOPE = (bf16_t*)(ws + WS_KNOPE); bf16_t* VT = (bf16_t*)(ws + WS_VT); bf16_t* GB = (bf16_t*)(ws + WS_G);
        bf16_t* MERGED = (bf16_t*)(ws + WS_MERGED); bf16_t* OA = CONVB; bf16_t* OC = CONVZ;
        LAS unsigned char* ldsl = (LAS unsigned char*)lds;

        const int layer = ph / 21, sub = ph - layer * 21;
        bool sync_after = true;
        if (ph == 84) {
            if (PON(48)) {
            LOCAL_LANE;
            const float* gf = ap->in[20];
            for (int row = gw; row < T; row += NGW) {
                f32x4* xr = (f32x4*)(X + (size_t)row * DM) + lane; const u32x2* xb = (const u32x2*)(HB + (size_t)row * DM) + lane; f32x4 v[4]; float s = 0.f;
#pragma unroll
                for (int j = 0; j < 4; ++j) { const u32x2 w = xb[64 * j]; v[j] = (f32x4){bflo(w.x), bfhi(w.x), bflo(w.y), bfhi(w.y)}; s += (v[j].x * v[j].x + v[j].y * v[j].y) + (v[j].z * v[j].z + v[j].w * v[j].w); }
                const float rs = rsqrtf(wave_sum(s) * (1.0f / DM) + EPS);
#pragma unroll
                for (int j = 0; j < 4; ++j) { const f32x4 g4 = ((const f32x4*)gf)[lane + 64 * j]; xr[64 * j] = v[j] * rs * g4; }
            }
            }
        } else if (sub == 3 || sub == 18) {
            continue;
        } else if (sub == 0 && PON(0)) {
            LOCAL_LANE;
            {
                if (layer == 0) {
                    for (int idx = bx * 512 + tid; idx < 8192 * 48; idx += G * 512) { const int pos = idx / 48, j = idx - pos * 48;
                        const bool ism = j < 16; const int jj = ism ? j : j - 16;
                        const float inv = exp2f(-(float)jj * (ism ? (1.0f / 16.0f) : (1.0f / 32.0f)) * 13.287712379549449f);
                        const float ang = (float)pos * inv; float* dst = ism ? TABM + ((size_t)pos * 16 + jj) * 2 : TABS + ((size_t)pos * 32 + jj) * 2;
                        dst[0] = cosf(ang); dst[1] = sinf(ang); }
                }
                float* scr = (float*)(lds + wave * 8448);
                const size_t L = (size_t)layer;
                for (int it = gw; it < 12784; it += NGW) {
                    int r = it;
                    if (r < 2816) { conv_item(ap->in[3] + L * 1024 * 5632, 1024, 5632, 0, r, ap->in[2] + L * 1024, Wb, scr, lane); continue; } r -= 2816;
                    if (r < 2816) { continue; } r -= 2816;
                    if (r < 2896) { conv_item(ap->in[6] + L * 1024 * 5792, 1024, 5792, 4, r, ap->in[5] + L * 1024, Wb, scr, lane); continue; } r -= 2896;
                    if (r < 1408) { conv_item(ap->in[4] + L * 2816 * 1024, 2816, 1024, 1, r, nullptr, Wb, scr, lane); continue; } r -= 1408;
                    if (r < 1408) { continue; } r -= 1408;
                    if (r < 512) { conv_item(ap->in[16] + L * 1024 * 1024, 1024, 1024, 10, r, nullptr, Wb, scr, lane); continue; } r -= 512;
                    if (r < 256) { conv_item(ap->in[11] + L * 512 * 1024, 512, 1024, 7, r, nullptr, Wb, scr, lane); continue; } r -= 256;
                    if (r < 256) { conv_item(ap->in[13] + L * 512 * 1024, 512, 1024, 8, r, nullptr, Wb, scr, lane); continue; } r -= 256;
                    if (r < 256) { conv_item(ap->in[15] + L * 512 * 1024, 512, 1024, 9, r, nullptr, Wb, scr, lane); continue; } r -= 256;
                    if (r < 96) { conv_item(ap->in[8] + L * 256 * 768, 256, 768, 5, r, ap->in[7] + L * 256, Wb, scr, lane); continue; } r -= 96;
                    conv_item(ap->in[10] + L * 128 * 1024, 128, 1024, 6, r, ap->in[9] + L * 128, Wb, scr, lane);
                }
            }
            if (layer == 0) {
                for (int row = gw; row < T; row += NGW) {
                    const float* src = row < TP ? ap->in[0] + (size_t)row * DM : ap->in[1] + (size_t)(row - TP) * DM;
                    const f32x4* xr = (const f32x4*)src + lane; f32x4 v[4]; float sq = 0.f;
#pragma unroll
                    for (int j = 0; j < 4; ++j) { v[j] = xr[64 * j]; sq += (v[j].x * v[j].x + v[j].y * v[j].y) + (v[j].z * v[j].z + v[j].w * v[j].w); }
                    sq = wave_sum(sq);
                    u32x2* o8 = (u32x2*)(HB + (size_t)row * DM) + lane;
#pragma unroll
                    for (int j = 0; j < 4; ++j) { u32x2 w; w.x = pk2(v[j].x, v[j].y); w.y = pk2(v[j].z, v[j].w); o8[64 * j] = w; }
                    if (lane < 16) ssq_x[(size_t)row * 16 + lane] = lane == 0 ? sq : 0.f;
                }
            }
        } else if ((sub == 1 || sub == 19) && PON(1)) {
            pg8::Gemm g{HB, (const bf16_t*)(Wb + (sub == 1 ? O_GU1 : O_GU2)), T, 2 * FF, DM, DM, DM}; pg8::StaticOrder S; S.init(T, 2 * FF, G, bx);
            EpiSwiGLU E{ACT, ssq_x};
            pg8::gemm_phase(ldsl, g, S, E, tid);
        } else if ((sub == 2 || sub == 20 || sub == 17) && PON(2)) {
            const bool wo = (sub == 17);
            const bf16_t* Aop = wo ? MERGED : ACT; const bf16_t* Bop = (const bf16_t*)(Wb + (sub == 2 ? O_DN1 : sub == 20 ? O_DN2 : O_WO));
            int Kd = wo ? DM : FF; asm volatile("" : "+s"(Kd));
            float alpha = wo ? 1.0f : 0.5f; asm volatile("" : "+v"(alpha));
            pg8::Gemm g; g.A = Aop; g.Bt = Bop; g.M = T; g.N = DM; g.K = Kd; g.lda = Kd; g.ldb = Kd;
            pg8::StaticOrder S; S.init(T, DM, G, bx);
            EpiResid E; E.X = X; E.alpha = alpha; E.XB = HB; E.ssq_x = ssq_x;
            pg8::gemm_phase(ldsl, g, S, E, tid);
            if (wo) {
                LOCAL_LANE;
                float* scr = (float*)(lds + wave * 8448);
                const size_t L = (size_t)layer;
                for (int it = gw; it < 2816 + 1408; it += NGW) {
                    if (it < 2816) conv_item(ap->in[18] + L * 1024 * 5632, 1024, 5632, 2, it, ap->in[17] + L * 1024, Wb, scr, lane);
                    else conv_item(ap->in[19] + L * 2816 * 1024, 2816, 1024, 3, it - 2816, nullptr, Wb, scr, lane);
                }
            }
        } else if (sub == 4 && PON(4)) {
            pg8::Gemm g{HB, (const bf16_t*)(Wb + O_WIN), T, 2816, DM, DM, DM}; pg8::StaticOrder S; S.init(T, 2816, G, bx);
            EpiWin E{LAT, CONVB, CONVZ, SWAQK, ssq_q, ssq_kv, TABM, TABS, ssq_x};
            pg8::gemm_phase(ldsl, g, S, E, tid);
            sync_after = false;
        } else if ((sub == 5 || sub == 9) && PON(5)) {
            const bool sv = sub == 5;
            pg8::Gemm g{(const bf16_t*)(Wb + (sv ? O_WSV : O_WUV)), sv ? HB : LAT + 256, sv ? 256 : 512, T, sv ? DM : 128, sv ? DM : 128, sv ? DM : 512};
            pg8::StaticOrder S; if (sv) S.init(256, T, 128, bx >= G - 128 ? bx - (G - 128) : (1 << 24)); else S.init(512, T, G, bx);
            EpiColScaleT E{sv ? SWAVT : VT, sv ? ssq_x : ssq_kv, sv ? 128 : 512, sv};
            pg8::gemm_phase(ldsl, g, S, E, tid);
        } else if (sub == 6 && PON(6)) {
            LOCAL_LANE;
            const float* cw = ap->in[12] + (size_t)layer * 1536; float w0[8], w1[8], w2[8];
#pragma unroll
            for (int e = 0; e < 8; ++e) { w0[e] = cw[8 * lane + e]; w1[e] = cw[512 + 8 * lane + e]; w2[e] = cw[1024 + 8 * lane + e]; }
            for (int row = gw; row < T; row += NGW) {
                const int pos = tok_pos(row), S_ = row < TP ? 4096 : 8192;
                const u32x4 zc = *(const u32x4*)(CONVZ + (size_t)row * 512 + 8 * lane), bb = *(const u32x4*)(CONVB + (size_t)row * 512 + 8 * lane);
                u32x4 zp = (u32x4){0u, 0u, 0u, 0u}, zn = zp;
                if (pos > 0) zp = *(const u32x4*)(CONVZ + (size_t)(row - 1) * 512 + 8 * lane);
                if (pos < S_ - 1) zn = *(const u32x4*)(CONVZ + (size_t)(row + 1) * 512 + 8 * lane);
                f32x4 c0, c1, p0, p1, n0, n1, b0, b1; unpack8(zc, c0, c1); unpack8(zp, p0, p1); unpack8(zn, n0, n1); unpack8(bb, b0, b1);
                f32x4 y0, y1;
#pragma unroll
                for (int e = 0; e < 4; ++e) { y0[e] = b0[e] * (w0[e] * p0[e] + w1[e] * c0[e] + w2[e] * n0[e]); y1[e] = b1[e] * (w0[4 + e] * p1[e] + w1[4 + e] * c1[e] + w2[4 + e] * n1[e]); }
                *(u32x4*)(CB + (size_t)row * 512 + 8 * lane) = pack8(y0, y1);
            }
            sync_after = false;
        } else if (sub == 7 && PON(7)) {
            pg8::Gemm g{LAT, (const bf16_t*)(Wb + O_WUQ), T, 768, 256, 512, 256}; pg8::StaticOrder S; S.init(T, 768, G, bx);
            EpiQ E{Q, ssq_q, TABM};
            pg8::gemm_phase(ldsl, g, S, E, tid);
            sync_after = false;
        } else if (sub == 8 && PON(8)) {
            pg8::Gemm g{LAT + 256, (const bf16_t*)(Wb + O_WUK), T, 512, 128, 512, 128}; pg8::StaticOrder S; S.init(T, 512, G, bx);
            EpiRowScale E{KNOPE, ssq_kv};
            pg8::gemm_phase(ldsl, g, S, E, tid);
            sync_after = false;
        } else if (sub == 10 && PON(10)) {
            LOCAL_LANE;
            const int wv = wave, l32 = lane & 31;
            for (int u = vcu; u < 512; u += G) {
                const int bh = u >> 5, qb = u & 31, b = bh >> 3, h = bh & 7; const size_t base = TP + (size_t)b * 8192; const size_t qrow = base + 256 * qb + 32 * wv + l32;
                attn_unit<false>(lds, ldsl, Q + qrow * 768 + h * 96, KNOPE + base * 512 + h * 64, 512, LAT + base * 512 + 384, VT + (size_t)(h * 64) * T + base, 128, -1e30f, 0.f, 0, OA + (qrow - l32) * 512 + h * 64, tid);
            }
            for (int u = vcu; u < 512; u += G) {
                const int bh = u >> 4, qb = u & 15, b = bh >> 3, h = bh & 7; const size_t base = (size_t)b * 4096; const size_t qrow = base + 256 * qb + 32 * wv + l32;
                attn_unit<false>(lds, ldsl, Q + qrow * 768 + h * 96, KNOPE + base * 512 + h * 64, 512, LAT + base * 512 + 384, VT + (size_t)(h * 64) * T + base, 64, -1e30f, 0.f, 0, OA + (qrow - l32) * 512 + h * 64, tid);
            }
            const float* sink = ap->in[14] + (size_t)layer * 8;
            for (int u = vcu * 4; u < 1024; u += G * 4)
                for (int k = 0; k < 4; ++k) {
                    const int uu = u + k, hp = uu & 1, g2 = (uu >> 1) & 1, nblk = uu >> 2; const int row0 = nblk * 128;
                    const int S_ = row0 < TP ? 4096 : 8192; const int base = row0 < TP ? (row0 & ~4095) : TP + ((row0 - TP) & ~8191);
                    const int n = (row0 - base) >> 7; const int t_lo = n > 0 ? 2 * (n - 1) : 0; int t_hi = 2 * (n + 2); if (t_hi > S_ / 64) t_hi = S_ / 64;
                    const int head = 4 * g2 + 2 * hp + (wv >> 2); const int qpos = 128 * n + 32 * (wv & 3) + l32; const size_t qrow = (size_t)base + qpos; const size_t kbase = (size_t)base + 64 * t_lo;
                    attn_unit<true>(lds, ldsl, SWAQK + qrow * 768 + head * 64, SWAQK + kbase * 768 + 512 + g2 * 64, 768, SWAQK, SWAVT + (size_t)(g2 * 64) * T + kbase, t_hi - t_lo,
                                    sink[head] * LOG2E, (lane >> 5) == 0 ? 1.0f : 0.0f, qpos - 64 * t_lo, OC + (qrow - l32) * 512 + head * 64, tid);
                }
        } else if (sub == 11 && PON(11)) {
            UnitMajor6 S; S.S.init(T, DM, G, bx);
            GSelMerge GS{ws, Wb};
            EpiGateMerge E{(unsigned char*)GB, MERGED, ssq_x};
            pg8::gemm_multi(ldsl, GS, S, E, tid);
        } else if (sub >= 12 && sub <= 16) {
            continue;
        }
        if (DUP_SUB >= 0 && sub == DUP_SUB && ph != 84 && !dup_done) { dup_done = true; --ph; xcd_barrier(xbar); continue; }
        dup_done = false;
        if (sync_after && ph + 1 < a.ph_hi) { if (ph == a.ph_lo) grid.sync(); else xcd_barrier(xbar); }
    }
}

extern "C" void kernel_launch(void* const* d_in, const int* in_sizes, int n_in, void* d_out, int out_size, void* d_ws, size_t ws_size, hipStream_t stream) {
    static int grid = 0;
    if (grid == 0) {
        if (n_in != 21 || out_size != T * DM || ws_size < WS_END) { fprintf(stderr, "kernel_launch: unexpected problem: n_in %d out %d ws %zu (need %zu)\n", n_in, out_size, ws_size, (size_t)WS_END); grid = -1; return; }
        int dev = 0, cus = 0, per_cu = 0;
        hipGetDevice(&dev); hipDeviceGetAttribute(&cus, hipDeviceAttributeMultiprocessorCount, dev);
        if (hipFuncSetAttribute((const void*)mk_fwd, hipFuncAttributeMaxDynamicSharedMemorySize, LDS_BYTES) != hipSuccess) { fprintf(stderr, "kernel_launch: hipFuncSetAttribute failed\n"); grid = -1; return; }
        if (hipOccupancyMaxActiveBlocksPerMultiprocessor(&per_cu, (const void*)mk_fwd, 512, LDS_BYTES) != hipSuccess || per_cu < 1) { fprintf(stderr, "kernel_launch: occupancy query says %d\n", per_cu); per_cu = 1; }
        (void)hipGetLastError();
        grid = cus;
    }
    if (grid < 0) return;
    Args a{};
    for (int i = 0; i < 21; ++i) a.in[i] = (const float*)d_in[i];
    a.out = (float*)d_out; a.ws = (unsigned char*)d_ws;
#if ONE_LAUNCH
    if (hipMemsetAsync((char*)d_ws + WS_BAR, 0, BAR_BYTES, stream) != hipSuccess) { fprintf(stderr, "kernel_launch: memset failed\n"); return; }
    a.ph_lo = 0; a.ph_hi = NPH;
    void* args[] = {&a};
    hipError_t e = hipLaunchCooperativeKernel((const void*)mk_fwd, dim3(grid), dim3(512), args, LDS_BYTES, stream);
    if (e != hipSuccess) fprintf(stderr, "kernel_launch: cooperative launch failed: %s (grid %d)\n", hipGetErrorString(e), grid);
#else
    for (int ph = 0; ph < NPH; ++ph) { a.ph_lo = ph; a.ph_hi = ph + 1; hipLaunchKernelGGL(mk_fwd, dim3(grid), dim3(512), LDS_BYTES, stream, a); }
#endif
}
```
